# Optimizing an MI355X kernel written in HIP

```python
import jax, jax.numpy as jnp
from jax import lax
import numpy as np

D_MODEL = 2048
BATCH = 2
SEQ = 8192
DEPTH = 2

N_A = DEPTH // 2
N_B = DEPTH - N_A
N_HEADS = 16
HEAD_DIM = D_MODEL // N_HEADS
D_FF = ((8 * D_MODEL // 3 + 255) // 256) * 256
CONV_WIDTH = 3
Q_BLOCK = 128
N_SUB = 3
N_MOD = 3
EPS = 1e-6

kernel_name = "yoco_shortconv_fox_macaron_adaln"


def rmsnorm(x, g):
    x32 = x.astype(jnp.float32)
    y = x32 * lax.rsqrt(jnp.mean(x32 * x32, axis=-1, keepdims=True) + EPS)
    return y.astype(x.dtype) * g


def modulate(h, shift, scale):
    return h * (1.0 + scale[:, None, :]) + shift[:, None, :]


def swiglu(h, w_in, w_out):
    a, b = jnp.split(h @ w_in, 2, axis=-1)
    return (jax.nn.silu(a) * b) @ w_out


def short_gated_conv(h, w_in, conv_w, conv_b, w_out):
    bg, cg, xv = jnp.split(h @ w_in, 3, axis=-1)
    u = cg * xv
    u = lax.conv_general_dilated(
        u, conv_w[:, None, :], window_strides=(1,),
        padding=[(CONV_WIDTH - 1, 0)],
        dimension_numbers=("NWC", "WIO", "NWC"),
        feature_group_count=D_MODEL) + conv_b
    return (bg * u) @ w_out


def forgetting_attention(q, k, v, fcum):
    b, s_len, h, dh = q.shape
    nb = s_len // Q_BLOCK
    scale = 1.0 / float(np.sqrt(dh))
    qb = q.reshape(b, nb, Q_BLOCK, h, dh).transpose(1, 0, 2, 3, 4)
    fb = fcum.reshape(b, h, nb, Q_BLOCK).transpose(2, 0, 1, 3)
    kpos = jnp.arange(s_len)

    def one_block(args):
        qi, fi, i = args
        logits = jnp.einsum("bqhd,bkhd->bhqk", qi, k,
                            preferred_element_type=jnp.float32) * scale
        logits = logits + fi[..., :, None] - fcum[:, :, None, :]
        qpos = i * Q_BLOCK + jnp.arange(Q_BLOCK)
        mask = qpos[:, None] >= kpos[None, :]
        logits = jnp.where(mask[None, None], logits, -jnp.inf)
        p = jax.nn.softmax(logits, axis=-1)
        return jnp.einsum("bhqk,bkhd->bqhd", p.astype(v.dtype), v)

    out = lax.map(one_block, (qb, fb, jnp.arange(nb)))
    return out.transpose(1, 0, 2, 3, 4).reshape(b, s_len, h * dh)


def setup_inputs(seed: int = 0) -> dict:
    key = jax.random.key(seed)
    ks = jax.random.split(key, 24)
    D, F, H = D_MODEL, D_FF, N_HEADS
    nrm = lambda k, shape, fan_in: jax.random.normal(k, shape, jnp.float32) * (fan_in ** -0.5)
    return {
        "x": jax.random.normal(ks[0], (BATCH, SEQ, D), jnp.float32),
        "c": jax.random.normal(ks[1], (BATCH, D), jnp.float32),
        "norm_g": 1.0 + 0.05 * jax.random.normal(ks[2], (DEPTH, N_SUB, D), jnp.float32),
        "w_ada": nrm(ks[3], (DEPTH, D, N_SUB * N_MOD * D), D),
        "b_ada": 0.02 * jax.random.normal(ks[4], (DEPTH, N_SUB * N_MOD * D), jnp.float32),
        "w_ffn_in": nrm(ks[5], (DEPTH, 2, D, 2 * F), D),
        "w_ffn_out": nrm(ks[6], (DEPTH, 2, F, D), F),
        "w_conv_in": nrm(ks[7], (N_A, D, 3 * D), D),
        "conv_w": nrm(ks[8], (N_A, CONV_WIDTH, D), CONV_WIDTH),
        "conv_b": 0.02 * jax.random.normal(ks[9], (N_A, D), jnp.float32),
        "w_conv_out": nrm(ks[10], (N_A, D, D), D),
        "kv_norm_g": 1.0 + 0.05 * jax.random.normal(ks[11], (D,), jnp.float32),
        "w_ada_kv": nrm(ks[12], (D, 2 * D), D),
        "b_ada_kv": 0.02 * jax.random.normal(ks[13], (2 * D,), jnp.float32),
        "w_kvf": jnp.concatenate([nrm(ks[14], (D, 2 * D), D),
                                  0.1 * nrm(ks[15], (D, H), D)], axis=-1),
        "b_fgate": jax.random.uniform(ks[16], (H,), jnp.float32, 1.0, 6.0),
        "w_q": nrm(ks[17], (N_B, D, D), D),
        "w_o": nrm(ks[18], (N_B, D, D), D),
        "final_g": 1.0 + 0.05 * jax.random.normal(ks[19], (D,), jnp.float32),
    }


def reference(x, c, norm_g, w_ada, b_ada, w_ffn_in, w_ffn_out, w_conv_in, conv_w, conv_b,
              w_conv_out, kv_norm_g, w_ada_kv, b_ada_kv, w_kvf, b_fgate, w_q, w_o, final_g):
    b, s_len, d = x.shape
    cond = jax.nn.silu(c)
    k = v = fcum = None
    for l in range(DEPTH):
        ada = (cond @ w_ada[l] + b_ada[l]).reshape(b, N_SUB, N_MOD, d)

        h = modulate(rmsnorm(x, norm_g[l, 0]), ada[:, 0, 0], ada[:, 0, 1])
        x = x + 0.5 * ada[:, 0, 2][:, None, :] * swiglu(h, w_ffn_in[l, 0], w_ffn_out[l, 0])

        h = modulate(rmsnorm(x, norm_g[l, 1]), ada[:, 1, 0], ada[:, 1, 1])
        if l < N_A:
            y = short_gated_conv(h, w_conv_in[l], conv_w[l], conv_b[l], w_conv_out[l])
        else:
            if l == N_A:
                ada_kv = (cond @ w_ada_kv + b_ada_kv).reshape(b, 2, d)
                hkv = modulate(rmsnorm(x, kv_norm_g), ada_kv[:, 0], ada_kv[:, 1])
                kvf = hkv @ w_kvf
                k = kvf[..., :d].reshape(b, s_len, N_HEADS, HEAD_DIM)
                v = kvf[..., d:2 * d].reshape(b, s_len, N_HEADS, HEAD_DIM)
                zf = (kvf[..., 2 * d:] + b_fgate).astype(jnp.float32)
                fcum = jnp.cumsum(jax.nn.log_sigmoid(zf), axis=1).transpose(0, 2, 1)
            j = l - N_A
            q = (h @ w_q[j]).reshape(b, s_len, N_HEADS, HEAD_DIM)
            y = forgetting_attention(q, k, v, fcum) @ w_o[j]
        x = x + ada[:, 1, 2][:, None, :] * y

        h = modulate(rmsnorm(x, norm_g[l, 2]), ada[:, 2, 0], ada[:, 2, 1])
        x = x + 0.5 * ada[:, 2, 2][:, None, :] * swiglu(h, w_ffn_in[l, 1], w_ffn_out[l, 1])
    return rmsnorm(x, final_g)
```

```cpp
#include <hip/hip_runtime.h>
#include <cstdio>
#include <cstdint>
namespace pg8 {
#define PG8_LAS __attribute__((address_space(3)))
typedef unsigned short bf16_t;
typedef short bf16x8 __attribute__((ext_vector_type(8)));
typedef float f32x4 __attribute__((ext_vector_type(4)));
typedef unsigned u32x4 __attribute__((ext_vector_type(4)));
constexpr int BM = 256, BK = 64, HALF = 128, HTB = HALF * BK * 2  , STAGE_BYTES = 8 * HTB, NXCD = 8, WGM = 8;

__host__ __device__ __forceinline__ int lds_byte(int r, int c) { const int st = (r >> 4) * 2 + (c >> 5), rr = r & 15, cc = c & 31, ob = rr * 64 + cc * 2; return st * 1024 + (ob ^ (((ob >> 9) & 1) << 5)); }
__host__ __device__ __forceinline__ void stage_rc(int b, int& R, int& C) { const int st = b / 1024, sb = b % 1024, swz = sb ^ (((sb >> 9) & 1) << 5); R = (st >> 1) * 16 + swz / 64; C = (st & 1) * 32 + (swz % 64) / 2; }
__host__ __device__ __forceinline__ int perm32(int rho) { const int n = rho >> 4, i = rho & 15; return 8 * (i >> 2) + 4 * n + (i & 3); }

struct Unit { int pm, pn; };
struct Gemm { const bf16_t* A; const bf16_t* Bt; int M, N, K; };

struct StaticOrder {
    int nM, nN, nwg, G, c;
    __host__ __device__ void init(int M, int N, int G_, int c_) { nM = M / BM; nN = N / BM; nwg = nM * nN; G = G_; c = c_; }
    __host__ __device__ bool next(int i, Unit& u) const {
        const long L = (long)i * G + c; if (L >= nwg) return false;
        int wgid = (int)L; { const int q = nwg / NXCD, r = nwg % NXCD, xcd = wgid % NXCD, off = wgid / NXCD; wgid = (xcd < r ? xcd * (q + 1) : r * (q + 1) + (xcd - r) * q) + off; }
        const int nig = WGM * nN, gid = wgid / nig, fm = gid * WGM, gsz = (nM - fm) < WGM ? (nM - fm) : WGM;
        u.pm = fm + ((wgid % nig) % gsz); u.pn = (wgid % nig) / gsz; return true;
    }
    __device__ __forceinline__ void a_ready(const Unit&) const {}
    __device__ __forceinline__ void done(const Unit&) const {}
};

__device__ __forceinline__ unsigned cvt_pk_bf16(float lo, float hi) { unsigned r; asm volatile("v_cvt_pk_bf16_f32 %0, %1, %2" : "=v"(r) : "v"(lo), "v"(hi)); return r; }
__device__ __forceinline__ float silu_f(float a) { return a * __builtin_amdgcn_rcpf(1.0f + __builtin_amdgcn_exp2f(a * -1.4426950408889634f)); }
__device__ __forceinline__ u32x4 pack8_bf16(const f32x4& v0, const f32x4& v1) { u32x4 w; w.x = cvt_pk_bf16(v0[0], v0[1]); w.y = cvt_pk_bf16(v0[2], v0[3]); w.z = cvt_pk_bf16(v1[0], v1[1]); w.w = cvt_pk_bf16(v1[2], v1[3]); return w; }

struct EpiSwiglu {
    static constexpr bool PERM = true, AFTER_DRAIN = false;
    bf16_t* O; int ldc;
    __device__ __forceinline__ void operator()(const f32x4 (&acc)[2][2][4][2], const Unit& u, int wr, int wc, int fr, int fq) const {
        const int row0 = u.pm * BM + wr * 64 + fr, col0 = u.pn * HALF + wc * 32 + 8 * fq;
#pragma unroll
        for (int ai = 0; ai < 2; ++ai)
#pragma unroll
            for (int m = 0; m < 4; ++m) { bf16_t* rowp = O + (size_t)(row0 + ai * HALF + m * 16) * ldc + col0;
                f32x4 v0, v1;
#pragma unroll
                for (int j = 0; j < 4; ++j) { v0[j] = silu_f(acc[ai][0][m][0][j]) * acc[ai][1][m][0][j]; v1[j] = silu_f(acc[ai][0][m][1][j]) * acc[ai][1][m][1][j]; }
                *(u32x4*)rowp = pack8_bf16(v0, v1); }
    }
};
struct EpiConvIn {
    static constexpr bool PERM = true, AFTER_DRAIN = false;
    bf16_t* BG; bf16_t* U; int ldc;
    __device__ __forceinline__ void operator()(const f32x4 (&acc)[2][2][4][2], const Unit& u, int wr, int wc, int fr, int fq) const {
        const int row0 = u.pm * BM + wr * 64 + fr;
        if (u.pn < 8) {
            const int col0 = u.pn * BM + wc * 32 + 8 * fq;
#pragma unroll
            for (int ai = 0; ai < 2; ++ai)
#pragma unroll
                for (int m = 0; m < 4; ++m) { bf16_t* rowp = BG + (size_t)(row0 + ai * HALF + m * 16) * ldc + col0;
#pragma unroll
                    for (int bj = 0; bj < 2; ++bj) *(u32x4*)(rowp + bj * HALF) = pack8_bf16(acc[ai][bj][m][0], acc[ai][bj][m][1]); }
        } else {
            const int col0 = (u.pn - 8) * HALF + wc * 32 + 8 * fq;
#pragma unroll
            for (int ai = 0; ai < 2; ++ai)
#pragma unroll
                for (int m = 0; m < 4; ++m) { bf16_t* rowp = U + (size_t)(row0 + ai * HALF + m * 16) * ldc + col0;
                    const f32x4 v0 = acc[ai][0][m][0] * acc[ai][1][m][0], v1 = acc[ai][0][m][1] * acc[ai][1][m][1];
                    *(u32x4*)rowp = pack8_bf16(v0, v1); }
        }
    }
};
struct EpiQKV {
    static constexpr bool PERM = true, AFTER_DRAIN = false;
    bf16_t* O; size_t stride; int ldc;
    __device__ __forceinline__ void operator()(const f32x4 (&acc)[2][2][4][2], const Unit& u, int wr, int wc, int fr, int fq) const {
        const int row0 = (u.pm & 63) * BM + wr * 64 + fr, col0 = (u.pn & 7) * BM + wc * 32 + 8 * fq; bf16_t* base = O + (size_t)(u.pn >> 3) * stride;
#pragma unroll
        for (int ai = 0; ai < 2; ++ai)
#pragma unroll
            for (int m = 0; m < 4; ++m) { bf16_t* rowp = base + (size_t)(row0 + ai * HALF + m * 16) * ldc + col0;
#pragma unroll
                for (int bj = 0; bj < 2; ++bj) *(u32x4*)(rowp + bj * HALF) = pack8_bf16(acc[ai][bj][m][0], acc[ai][bj][m][1]); }
    }
};
struct EpiResid {
    static constexpr bool PERM = false, AFTER_DRAIN = false;
    const float* base; float* out; int ldc; const float* gate; int gstride; float sc;
    __device__ __forceinline__ void operator()(const f32x4 (&acc)[2][2][4][2], const Unit& u, int wr, int wc, int fr, int fq) const {
        const int col0 = u.pn * BM + wc * 32 + 4 * fq; const float* gv = gate + (size_t)(u.pm >> 5) * gstride + col0;
#pragma unroll
        for (int bj = 0; bj < 2; ++bj)
#pragma unroll
            for (int n = 0; n < 2; ++n) { const f32x4 g4 = *(const f32x4*)(gv + bj * HALF + n * 16) * sc;
#pragma unroll
                for (int ai = 0; ai < 2; ++ai)
#pragma unroll
                    for (int m = 0; m < 4; ++m) { const size_t off = (size_t)(u.pm * BM + ai * HALF + wr * 64 + m * 16 + fr) * ldc + col0 + bj * HALF + n * 16;
                        const f32x4 bs = *(const f32x4*)(base + off); *(f32x4*)(out + off) = bs + g4 * acc[ai][bj][m][n]; } }
    }
};
struct QkvOrder : StaticOrder {
    __device__ __forceinline__ bool next(int i, Unit& u) const { if (!StaticOrder::next(i, u)) return false; if (u.pn >= 8) u.pm += 64; return true; }
};
template <class Epi, class Sched, bool ALIGN_EPI = false, bool SP2 = false>
__device__ __forceinline__ void gemm_phase(PG8_LAS unsigned char* lds, const Gemm g, const Sched& S, const Epi& E) {
    int tid_ = threadIdx.x; asm volatile("" : "+v"(tid_));
    const int tid = tid_, wid = __builtin_amdgcn_readfirstlane(tid >> 6), lane = tid & 63, wr = wid >> 2, wc = wid & 3, fr = lane & 15, fq = lane >> 4;
    const int K = g.K, nt = K / BK;
    unsigned voffA[2], voffB[2];
#pragma unroll
    for (int i = 0; i < 2; ++i) { int R, C; stage_rc(tid * 16 + i * 8192, R, C); const int Rb = Epi::PERM ? ((R & ~31) + perm32(R & 31)) : R;
        voffA[i] = (unsigned)(R * K + C) * 2u; voffB[i] = (unsigned)(Rb * K + C) * 2u; }
    const size_t kstep = (size_t)(BK * 2);
    const size_t hstep = (size_t)HALF * K * 2;
    const size_t tstep = 2 * hstep;
    const unsigned ldsw = (unsigned)wid * 1024u;
    const int aoff = lds_byte(wr * 64 + fr, fq * 8), boff = lds_byte(wc * 32 + fr, fq * 8);
#define PG8_SA(b, h) (((b) * 2 + (h)) * HTB)
#define PG8_SB(b, h) ((4 + (b) * 2 + (h)) * HTB)
#define PG8_STAGE(bufoff, gbase, voff) do { _Pragma("unroll") for (int _i = 0; _i < 2; ++_i) \
        __builtin_amdgcn_global_load_lds((const unsigned*)((const char*)(gbase) + (voff)[_i]), (PG8_LAS unsigned*)(lds + (bufoff) + ldsw + _i * 8192), 16, 0, 0); } while (0)
#define PG8_LDA(dst, b, h) do { _Pragma("unroll") for (int m = 0; m < 4; ++m) _Pragma("unroll") for (int k = 0; k < 2; ++k) dst[m][k] = *(const PG8_LAS bf16x8*)(lds + PG8_SA(b, h) + aoff + m * 2048 + k * 1024); } while (0)
#define PG8_LDB(dst, b, h) do { _Pragma("unroll") for (int n = 0; n < 2; ++n) _Pragma("unroll") for (int k = 0; k < 2; ++k) dst[n][k] = *(const PG8_LAS bf16x8*)(lds + PG8_SB(b, h) + boff + n * 2048 + k * 1024); } while (0)
#define PG8_MMA(ai, bj, At, Bt) do { __builtin_amdgcn_s_setprio(1); _Pragma("unroll") for (int m = 0; m < 4; ++m) _Pragma("unroll") for (int n = 0; n < 2; ++n) _Pragma("unroll") for (int k = 0; k < 2; ++k) \
        acc[ai][bj][m][n] = __builtin_amdgcn_mfma_f32_16x16x32_bf16(Bt[n][k], At[m][k], acc[ai][bj][m][n], 0, 0, 0); __builtin_amdgcn_s_setprio(0); } while (0)
#define PG8_WAIT_V(n) asm volatile("s_waitcnt vmcnt(" #n ")" ::: "memory")
#define PG8_WAIT_L(n) asm volatile("s_waitcnt lgkmcnt(" #n ")" ::: "memory")
#define PG8_BAR __builtin_amdgcn_s_barrier()
#define PG8_SCHED __builtin_amdgcn_sched_barrier(0)
    Unit cur, nxt; int ui = 0;
    if (!S.next(0, cur)) return;
    f32x4 acc[2][2][4][2];
#pragma unroll
    for (int a = 0; a < 2; ++a)
#pragma unroll
        for (int b = 0; b < 2; ++b)
#pragma unroll
            for (int m = 0; m < 4; ++m)
#pragma unroll
                for (int n = 0; n < 2; ++n) acc[a][b][m][n] = (f32x4){0.f, 0.f, 0.f, 0.f};
    bf16x8 At[4][2], B0[2][2], B1[2][2];
    const char* cA = (const char*)g.A + (size_t)cur.pm * tstep; const char* cB = (const char*)g.Bt + (size_t)cur.pn * tstep;
    S.a_ready(cur);
    if constexpr (SP2) {
        PG8_STAGE(PG8_SB(0, 0), cB, voffB); PG8_STAGE(PG8_SB(0, 1), cB + hstep, voffB); PG8_STAGE(PG8_SA(0, 0), cA, voffA); PG8_STAGE(PG8_SA(0, 1), cA + hstep, voffA);
        if (wr == 1) PG8_BAR;
        PG8_WAIT_V(2); PG8_BAR;
        PG8_STAGE(PG8_SB(1, 0), cB + kstep, voffB); PG8_STAGE(PG8_SA(1, 0), cA + kstep, voffA); PG8_STAGE(PG8_SB(1, 1), cB + hstep + kstep, voffB);
        PG8_WAIT_V(6); PG8_BAR;
    } else {
        PG8_STAGE(PG8_SB(0, 0), cB, voffB); PG8_STAGE(PG8_SA(0, 0), cA, voffA); PG8_STAGE(PG8_SB(0, 1), cB + hstep, voffB); PG8_STAGE(PG8_SA(0, 1), cA + hstep, voffA);
        if (wr == 1) PG8_BAR;
        PG8_WAIT_V(4); PG8_BAR;
        PG8_STAGE(PG8_SB(1, 0), cB + kstep, voffB); PG8_STAGE(PG8_SA(1, 0), cA + kstep, voffA); PG8_STAGE(PG8_SB(1, 1), cB + hstep + kstep, voffB);
        PG8_WAIT_V(6); PG8_BAR;
    }
    for (;;) {
        const bool has_next = S.next(ui + 1, nxt);
        const char* nA = has_next ? (const char*)g.A + (size_t)nxt.pm * tstep : cA; const char* nB = has_next ? (const char*)g.Bt + (size_t)nxt.pn * tstep : cB;
        for (int t = 0; t < nt; t += 2) {
            const bool last = (t == nt - 2);
            const char* a1 = cA + (size_t)(t + 1) * kstep;
            const char* a2 = last ? nA : cA + (size_t)(t + 2) * kstep; const char* b2 = last ? nB : cB + (size_t)(t + 2) * kstep;
            const char* a3 = a2 + kstep; const char* b3 = b2 + kstep;
            if (last && has_next) S.a_ready(nxt);
            if constexpr (SP2) {
            PG8_LDB(B0, 0, 0); PG8_LDB(B1, 0, 1); PG8_SCHED; PG8_LDA(At, 0, 0); PG8_STAGE(PG8_SA(1, 1), a1 + hstep, voffA);
            PG8_WAIT_V(8); PG8_WAIT_L(0); PG8_BAR; PG8_MMA(0, 0, At, B0); PG8_MMA(0, 1, At, B1); PG8_BAR; PG8_SCHED;
            PG8_LDA(At, 0, 1); PG8_STAGE(PG8_SB(0, 0), b2, voffB); PG8_STAGE(PG8_SB(0, 1), b2 + hstep, voffB); PG8_STAGE(PG8_SA(0, 0), a2, voffA);
            PG8_WAIT_V(8); PG8_WAIT_L(0); PG8_BAR; PG8_MMA(1, 0, At, B0); PG8_MMA(1, 1, At, B1); PG8_BAR; PG8_SCHED;
            PG8_LDB(B0, 1, 0); PG8_LDB(B1, 1, 1); PG8_SCHED; PG8_LDA(At, 1, 0); PG8_STAGE(PG8_SA(0, 1), a2 + hstep, voffA);
            PG8_WAIT_V(8); PG8_WAIT_L(0); PG8_BAR; PG8_MMA(0, 0, At, B0); PG8_MMA(0, 1, At, B1); PG8_BAR; PG8_SCHED;
            PG8_LDA(At, 1, 1); PG8_STAGE(PG8_SB(1, 0), b3, voffB); PG8_STAGE(PG8_SB(1, 1), b3 + hstep, voffB); PG8_STAGE(PG8_SA(1, 0), a3, voffA);
            PG8_WAIT_V(8); PG8_WAIT_L(0); PG8_BAR; PG8_MMA(1, 0, At, B0); PG8_MMA(1, 1, At, B1); PG8_BAR; PG8_SCHED;
            } else {
            PG8_LDB(B0, 0, 0); PG8_SCHED; PG8_LDA(At, 0, 0); PG8_STAGE(PG8_SA(1, 1), a1 + hstep, voffA);
            PG8_WAIT_L(8); PG8_BAR; PG8_WAIT_L(0); PG8_MMA(0, 0, At, B0); PG8_BAR; PG8_SCHED;
            PG8_LDB(B1, 0, 1); PG8_STAGE(PG8_SB(0, 0), b2, voffB);
            PG8_BAR; PG8_WAIT_L(0); PG8_MMA(0, 1, At, B1); PG8_BAR;
            PG8_LDA(At, 0, 1); PG8_STAGE(PG8_SA(0, 0), a2, voffA);
            PG8_BAR; PG8_WAIT_L(0); PG8_MMA(1, 0, At, B0); PG8_BAR; PG8_SCHED;
            PG8_STAGE(PG8_SB(0, 1), b2 + hstep, voffB);
            PG8_WAIT_V(6); PG8_BAR; PG8_MMA(1, 1, At, B1); PG8_BAR;
            PG8_LDB(B0, 1, 0); PG8_SCHED; PG8_LDA(At, 1, 0); PG8_STAGE(PG8_SA(0, 1), a2 + hstep, voffA);
            PG8_WAIT_L(8); PG8_BAR; PG8_WAIT_L(0); PG8_MMA(0, 0, At, B0); PG8_BAR; PG8_SCHED;
            PG8_LDB(B1, 1, 1); PG8_STAGE(PG8_SB(1, 0), b3, voffB);
            PG8_BAR; PG8_WAIT_L(0); PG8_MMA(0, 1, At, B1); PG8_BAR;
            PG8_LDA(At, 1, 1); PG8_STAGE(PG8_SA(1, 0), a3, voffA);
            PG8_BAR; PG8_WAIT_L(0); PG8_MMA(1, 0, At, B0); PG8_BAR; PG8_SCHED;
            PG8_STAGE(PG8_SB(1, 1), b3 + hstep, voffB);
            PG8_WAIT_V(6); PG8_BAR; PG8_MMA(1, 1, At, B1); PG8_BAR;
            }
        }
        if constexpr (ALIGN_EPI) { if (wr == 0) PG8_BAR; }
        if constexpr (!Epi::AFTER_DRAIN) { E(acc, cur, wr, wc, fr, fq); S.done(cur); }
        if (!has_next) break;
#pragma unroll
        for (int a = 0; a < 2; ++a)
#pragma unroll
            for (int b = 0; b < 2; ++b)
#pragma unroll
                for (int m = 0; m < 4; ++m)
#pragma unroll
                    for (int n = 0; n < 2; ++n) acc[a][b][m][n] = (f32x4){0.f, 0.f, 0.f, 0.f};
        cur = nxt; cA = nA; cB = nB; ++ui;
        if constexpr (ALIGN_EPI) { if (wr == 1) PG8_BAR; }
    }
    PG8_WAIT_V(0);
    if constexpr (!ALIGN_EPI) { if (wr == 0) PG8_BAR; }
    PG8_BAR;
    if constexpr (Epi::AFTER_DRAIN) { E.fused(acc, cur, wr, wc, fr, fq, lds, wid, lane); S.done(cur); }
#undef PG8_SA
#undef PG8_SB
#undef PG8_STAGE
#undef PG8_LDA
#undef PG8_LDB
#undef PG8_MMA
#undef PG8_WAIT_V
#undef PG8_WAIT_L
#undef PG8_BAR
#undef PG8_SCHED
}
}
namespace fox {
enum { ORDER_NATURAL = 0, ORDER_REVERSED = 1, ORDER_PAIRED = 2, ORDER_XCD = 4 };
constexpr int B = 2, H = 16, HKV = 16, SQ = 8192, SKV = 8192, D = 128, PITCH = 2048;
constexpr int QOFF = 0;
constexpr int WINDOW = 1 << 30;
constexpr float THR = 8.f;
constexpr bool WSKIP = false;
constexpr float SCALE = 0.08838834764831845f;
constexpr int NW = 8, QBLK = 32, KVBLK = 64, QB = NW * QBLK;
constexpr int SHM_V = KVBLK * D * 2, SHM_K = KVBLK * D * 2;
constexpr int BIAS_OFF = 2 * SHM_V + 2 * SHM_K + NW * 64 * 4;
constexpr int LDS_BYTES = BIAS_OFF + 2 * 64 * 4;
static_assert(D == 128 && SQ % QB == 0 && SKV % KVBLK == 0 && H % HKV == 0 && QOFF >= 0 && QOFF + SQ <= SKV && WINDOW >= 1, "geometry");

typedef unsigned short bf16;
typedef short bf16x8 __attribute__((ext_vector_type(8)));
typedef short s16x4 __attribute__((ext_vector_type(4)));
typedef float f32x16 __attribute__((ext_vector_type(16)));
typedef float f32x4 __attribute__((ext_vector_type(4)));
typedef unsigned u32x4 __attribute__((ext_vector_type(4)));
template <class A, class Bt> struct same_t { static constexpr bool v = false; };
template <class A> struct same_t<A, A> { static constexpr bool v = true; };

#define KSWZ(row, colB) ((row) * 256 + ((colB) ^ (((row) & 7) << 4)))
#define SBAR() __builtin_amdgcn_sched_barrier(0)
__device__ __forceinline__ int v_st(int k, int c) { const int kk = (k & ~0xC) | ((k & 4) << 1) | ((k & 8) >> 1); return ((kk >> 3) * 4 + (c >> 5)) * 512 + ((kk & 7) * 32 + (c & 31)) * 2; }
__device__ __forceinline__ int v_rd_base(int lane) { return ((lane & 3) << 3) | (((lane >> 2) & 3) << 6) | (((lane >> 4) & 1) << 5) | (((lane >> 5) & 1) << 8); }
constexpr int v_rd_off(int d0, int ks, int half) { return d0 * 512 + ks * 4096 + half * 2048; }
__device__ __forceinline__ int crow(int r, int hi) { return (r & 3) + 8 * (r >> 2) + 4 * hi; }
__device__ __forceinline__ unsigned cvtpk(float lo, float hi) {
    unsigned r; asm volatile("v_cvt_pk_bf16_f32 %0, %1, %2" : "=v"(r) : "v"(lo), "v"(hi)); return r;
}
__device__ __forceinline__ bf16x8 pack8(f32x4 a, f32x4 b) {
    u32x4 w = {cvtpk(a[0], a[1]), cvtpk(a[2], a[3]), cvtpk(b[0], b[1]), cvtpk(b[2], b[3])};
    return *reinterpret_cast<bf16x8*>(&w);
}
template <class T> __device__ __forceinline__ bf16x8 load8(const T* p) {
    if constexpr (same_t<T, float>::v) { return pack8(*(const f32x4*)p, *(const f32x4*)(p + 4)); }
    else { return *reinterpret_cast<const bf16x8*>(p); }
}
__device__ __forceinline__ void mask_tile(f32x16& p0, f32x16& p1, int dq, unsigned W) {
    const float NEG = -__builtin_inff();
#pragma unroll
    for (int r = 0; r < 16; ++r) {
        const int c = (r & 3) + 8 * (r >> 2);
        if ((unsigned)(dq - c) >= W) p0[r] = NEG;
        if ((unsigned)(dq - c - 32) >= W) p1[r] = NEG;
    }
}
__device__ __forceinline__ void partialSM(f32x16& p0, f32x16& p1, float& m_reg, float& mn, float& alpha) {
    float pmax = p0[0]; for (int r = 1; r < 16; ++r) pmax = fmaxf(pmax, p0[r]); for (int r = 0; r < 16; ++r) pmax = fmaxf(pmax, p1[r]);
    { auto rr = __builtin_amdgcn_permlane32_swap(__float_as_uint(pmax), __float_as_uint(pmax), false, false);
      pmax = fmaxf(__uint_as_float(rr[0]), __uint_as_float(rr[1])); }
    constexpr float C2 = 1.4426950408889634f * SCALE;
    if (__builtin_expect(__all((pmax - m_reg) * SCALE <= THR), 1)) { mn = m_reg; alpha = 1.f; }
    else { mn = fmaxf(m_reg, pmax); alpha = __builtin_amdgcn_exp2f((m_reg - mn) * C2); m_reg = mn; }
    const float mnL = -mn * C2;
    for (int r = 0; r < 16; ++r) p0[r] = fmaf(p0[r], C2, mnL); for (int r = 0; r < 16; ++r) p1[r] = fmaf(p1[r], C2, mnL);
    for (int r = 0; r < 16; ++r) p0[r] = __builtin_amdgcn_exp2f(p0[r]);
}
__device__ __forceinline__ void finishSM(f32x16& p0, f32x16& p1, float alpha, float& l_reg, bf16x8& pa0, bf16x8& pa1, bf16x8& pa2, bf16x8& pa3) {
    for (int r = 0; r < 16; ++r) p1[r] = __builtin_amdgcn_exp2f(p1[r]);
    float ps = 0; for (int r = 0; r < 16; ++r) ps += p0[r]; for (int r = 0; r < 16; ++r) ps += p1[r];
    { auto rr = __builtin_amdgcn_permlane32_swap(__float_as_uint(ps), __float_as_uint(ps), false, false);
      ps = __uint_as_float(rr[0]) + __uint_as_float(rr[1]); }
    l_reg = l_reg * alpha + ps;
#define PK4(P, B_, OUT) do { unsigned a0 = cvtpk(P[B_+0], P[B_+1]), a1 = cvtpk(P[B_+2], P[B_+3]);                          \
        unsigned b0 = cvtpk(P[B_+4], P[B_+5]), b1 = cvtpk(P[B_+6], P[B_+7]);                                             \
        auto r0 = __builtin_amdgcn_permlane32_swap(a0, b0, false, false); auto r1 = __builtin_amdgcn_permlane32_swap(a1, b1, false, false); \
        u32x4 w = {r0[0], r1[0], r0[1], r1[1]}; OUT = *reinterpret_cast<bf16x8*>(&w); } while (0)
    PK4(p0, 0, pa0); PK4(p0, 8, pa1); PK4(p1, 0, pa2); PK4(p1, 8, pa3);
#undef PK4
}
template <int KB, bool SK>
__device__ __forceinline__ void qkt(f32x16& p0, f32x16& p1, const char* K_lds, const float* B_lds, int r32, int hi, const bf16x8* qr, bool act) {
    if (SK && !act) { const float NEG = -__builtin_inff();
#pragma unroll
        for (int r = 0; r < 16; ++r) { p0[r] = NEG; p1[r] = NEG; } return; }
    { const float* bb = B_lds + KB * 64 + 4 * hi;
#pragma unroll
      for (int g = 0; g < 4; ++g) { const f32x4 v0 = *(const f32x4*)(bb + 8 * g), v1 = *(const f32x4*)(bb + 32 + 8 * g);
#pragma unroll
        for (int j = 0; j < 4; ++j) { p0[4 * g + j] = v0[j]; p1[4 * g + j] = v1[j]; } } }
    const char* kb[4];
#pragma unroll
    for (int dd = 0; dd < 4; ++dd) kb[dd] = K_lds + KB * SHM_K + KSWZ(r32, (dd * 16 + hi * 8) * 2);
#pragma unroll
    for (int d0 = 0; d0 < 8; ++d0) { const char* a = kb[d0 & 3] + (d0 >> 2) * 128;
        bf16x8 b0 = *reinterpret_cast<const bf16x8*>(a);
        bf16x8 b1 = *reinterpret_cast<const bf16x8*>(a + 32 * 256);
        p0 = __builtin_amdgcn_mfma_f32_32x32x16_bf16(b0, qr[d0], p0, 0, 0, 0);
        p1 = __builtin_amdgcn_mfma_f32_32x32x16_bf16(b1, qr[d0], p1, 0, 0, 0); }
}
template <int VB, bool SK>
__device__ __forceinline__ void pv_tile(f32x16* o, int vb0, bf16x8 pa0, bf16x8 pa1, bf16x8 pa2, bf16x8 pa3, bool act) {
    if (SK && !act) return;
#define TRRD(dst, off) asm volatile("ds_read_b64_tr_b16 %0, %1 offset:%2" : "=&v"(dst) : "v"(vb0), "i"(off) : "memory")
#define PV_D0(d0) do { s16x4 l0, l1, l2, l3, h0, h1, h2, h3; constexpr int b_ = VB * SHM_V + v_rd_off(d0, 0, 0);     \
        TRRD(l0, b_); TRRD(h0, b_ + 2048); TRRD(l1, b_ + 4096); TRRD(h1, b_ + 6144); TRRD(l2, b_ + 8192); TRRD(h2, b_ + 10240); TRRD(l3, b_ + 12288); TRRD(h3, b_ + 14336); \
        asm volatile("s_waitcnt lgkmcnt(0)" ::: "memory"); SBAR();                 \
        o[d0] = __builtin_amdgcn_mfma_f32_32x32x16_bf16(pa0, (bf16x8){l0[0], l0[1], l0[2], l0[3], h0[0], h0[1], h0[2], h0[3]}, o[d0], 0, 0, 0);   \
        o[d0] = __builtin_amdgcn_mfma_f32_32x32x16_bf16(pa1, (bf16x8){l1[0], l1[1], l1[2], l1[3], h1[0], h1[1], h1[2], h1[3]}, o[d0], 0, 0, 0);   \
        o[d0] = __builtin_amdgcn_mfma_f32_32x32x16_bf16(pa2, (bf16x8){l2[0], l2[1], l2[2], l2[3], h2[0], h2[1], h2[2], h2[3]}, o[d0], 0, 0, 0);   \
        o[d0] = __builtin_amdgcn_mfma_f32_32x32x16_bf16(pa3, (bf16x8){l3[0], l3[1], l3[2], l3[3], h3[0], h3[1], h3[2], h3[3]}, o[d0], 0, 0, 0); } while (0)
    PV_D0(0); PV_D0(1); PV_D0(2); PV_D0(3);
#undef PV_D0
#undef TRRD
}

__device__ __forceinline__ void glds4(const float* gbase, unsigned voff, unsigned lds_dst) { unsigned keep;
    asm volatile("s_mov_b32 %0, m0\n\ts_mov_b32 m0, %3\n\ts_nop 0\n\tglobal_load_lds_dword %1, %2\n\ts_mov_b32 m0, %0" : "=&s"(keep) : "v"(voff), "s"(gbase), "s"(lds_dst) : "memory"); }
template <class TIn, class TOut> struct BlockRef { const TIn* Q; const TIn* K; const TIn* V; TOut* O; const float* F; int P0; };
template <class TIn> struct Seam {
    bf16x8 qr[8];
    bf16x8 st_v0, st_v1, st_k0, st_k1; f32x4 sf0, sf1, sf2, sf3;
    f32x4 tq[16];
};
__device__ __forceinline__ int swa_jlo(int P0, int W) { const int lowk = P0 - W + 1; return lowk > 0 ? lowk / KVBLK : 0; }
#define ROW(p, k0, rr) ((p) + (size_t)((k0) + (rr)) * PITCH + sc)
#define ROWU(p, k0, add) ((const TIn*)((const char*)((p) + (size_t)((k0) + (add)) * PITCH) + so0))
#define VMW() asm volatile("s_waitcnt vmcnt(0)" ::: "memory")
#define VMWN(n) asm volatile("s_waitcnt vmcnt(%0)" :: "i"(n) : "memory")
#define SLOAD_H(Kp, Vp, Fp, k0) do { S.st_v0 = load8<TIn>(ROWU(Vp, k0, 0)); S.st_v1 = load8<TIn>(ROWU(Vp, k0, 32));              \
                         S.st_k0 = load8<TIn>(ROWU(Kp, k0, 0)); S.st_k1 = load8<TIn>(ROWU(Kp, k0, 32)); } while (0)
#define SWRITE_HK(bf) do { *(bf16x8*)(K_lds + (bf) * SHM_K + kws) = S.st_k0; *(bf16x8*)(K_lds + (bf) * SHM_K + kws + 32 * 256) = S.st_k1; } while (0)
#define SWRITE_HV(bf) do { *(bf16x8*)(V_lds + (bf) * SHM_V + vst0) = S.st_v0; *(bf16x8*)(V_lds + (bf) * SHM_V + vst1) = S.st_v1; } while (0)
#define SWRITE_H(bf) do { SWRITE_HV(bf); SWRITE_HK(bf); } while (0)
#define BLOAD(Fp, k0, bf) do { if (wid == 0) glds4((Fp) + (k0), (unsigned)(lane * 4), lds_b0 + (bf) * 256); } while (0)
#define SLOAD_F(p, k0) do { S.sf0 = *(const f32x4*)ROW(p, k0, sr); S.sf1 = *(const f32x4*)(ROW(p, k0, sr) + 4);                \
                            S.sf2 = *(const f32x4*)ROW(p, k0, 32 + sr); S.sf3 = *(const f32x4*)(ROW(p, k0, 32 + sr) + 4); } while (0)
#define SWRITE_KF(bf) do { *(bf16x8*)(K_lds + (bf) * SHM_K + kws) = pack8(S.sf0, S.sf1); *(bf16x8*)(K_lds + (bf) * SHM_K + kws + 32 * 256) = pack8(S.sf2, S.sf3); } while (0)
#define SWRITE_VF(bf) do { *(bf16x8*)(V_lds + (bf) * SHM_V + vst0) = pack8(S.sf0, S.sf1); *(bf16x8*)(V_lds + (bf) * SHM_V + vst1) = pack8(S.sf2, S.sf3); } while (0)
template <class TIn, class TOut>
__device__ __forceinline__ void causal_swa_prime(const BlockRef<TIn, TOut>& cur, int W, char* lds, Seam<TIn>& S) {
    constexpr bool F32 = same_t<TIn, float>::v;
    const int tid = threadIdx.x, wid = __builtin_amdgcn_readfirstlane(tid >> 6), lane = tid & 63, r32 = lane & 31, hi = lane >> 5;
    const int sr = tid >> 4, sc = (tid & 15) * 8, kws = KSWZ(sr, sc * 2); const unsigned so0 = (unsigned)(sr * PITCH + sc) * 2u; char* K_lds = lds + 2 * SHM_V; const unsigned lds_b0 = (unsigned)__builtin_amdgcn_readfirstlane((int)(uintptr_t)lds + BIAS_OFF);
    const int kb0 = swa_jlo(cur.P0, W) * KVBLK;
    { const unsigned qo0 = (unsigned)(r32 * PITCH + hi * 8) * 2u; const char* qb_ = (const char*)(cur.Q + (size_t)(wid * QBLK) * PITCH);
      for (int d0 = 0; d0 < 8; ++d0) S.qr[d0] = load8<TIn>((const TIn*)(qb_ + qo0) + d0 * 16); }
    if constexpr (F32) { SLOAD_F((const float*)cur.K, kb0); VMW(); SWRITE_KF(0); SBAR(); SLOAD_F((const float*)cur.V, kb0); }
    else { SLOAD_H(cur.K, cur.V, cur.F, kb0); BLOAD(cur.F, kb0, 0); VMW(); SWRITE_HK(0); }
    __syncthreads();
}
template <class TIn, class TOut>
__device__ __forceinline__ void causal_swa_block(const BlockRef<TIn, TOut>& cur, const BlockRef<TIn, TOut>& nxt, int skv, int W, char* lds, Seam<TIn>& S) {
    constexpr bool F32 = same_t<TIn, float>::v;
    const int tid = threadIdx.x, wid = __builtin_amdgcn_readfirstlane(tid >> 6), lane = tid & 63, r32 = lane & 31, hi = lane >> 5;
    const int j_lo = swa_jlo(cur.P0, W);
    int j_hi = (cur.P0 + QB - 1) / KVBLK + 1; if (j_hi > skv / KVBLK) j_hi = skv / KVBLK;
    const int NT = j_hi - j_lo;
    const int kbn = swa_jlo(nxt.P0, W) * KVBLK;
    const int qlo = cur.P0 + wid * QBLK, qm = qlo + r32 - 4 * hi;
    char* V_lds = lds; char* K_lds = lds + 2 * SHM_V; const float* B_lds = (const float*)(lds + BIAS_OFF); const unsigned lds_b0 = (unsigned)__builtin_amdgcn_readfirstlane((int)(uintptr_t)lds + BIAS_OFF);
    float* ws = (float*)(lds + 2 * SHM_V + 2 * SHM_K) + wid * 64; float* li_l = ws, * al_l = ws + 32;
    float m_reg = -1e30f, l_reg = 0; f32x16 o[4] = {};
    const int sr = tid >> 4, sc = (tid & 15) * 8, vst0 = v_st(sr, sc), vst1 = v_st(32 + sr, sc), kws = KSWZ(sr, sc * 2); const unsigned so0 = (unsigned)(sr * PITCH + sc) * 2u, qo0 = (unsigned)(r32 * PITCH + hi * 8) * 2u;
    const int vb0 = (int)(uintptr_t)V_lds + v_rd_base(lane);
    const TIn* Kh = cur.K; const TIn* Vh = cur.V; const float* Fh = cur.F;
#define RESC(a) do { if (__any((a) < 1.f)) { if (hi == 0) al_l[r32] = (a); asm volatile("s_waitcnt lgkmcnt(0)" ::: "memory");              \
                     for (int d_ = 0; d_ < 4; ++d_) for (int r = 0; r < 16; ++r) o[d_][r] *= al_l[crow(r, hi)]; } } while (0)
#define KBASE(t) ((j_lo + (t)) * KVBLK)
#define ACT(t) (KBASE(t) <= qlo + QBLK - 1 && KBASE(t) + KVBLK - 1 >= qlo - W + 1)
#define MASKT(P0_, P1_, t) do { const int kb_ = KBASE(t); if ((!SK || ACT(t)) && (kb_ + KVBLK - 1 > qlo || kb_ <= qlo + QBLK - 1 - W)) mask_tile(P0_, P1_, qm - kb_, (unsigned)W); } while (0)
    constexpr int NQL = F32 ? 16 : 8;
    constexpr bool SK = WSKIP && !F32;
#define SEAM_K0() do { VMWN(NQL); if constexpr (F32) { SWRITE_KF(0); SBAR(); SLOAD_F((const float*)nxt.V, kbn); } else { SWRITE_HK(0); } SBAR(); } while (0)
    f32x16 pA0, pA1, pB0, pB1; float mnA, mnB, alA, alB; bf16x8 pa0, pa1, pa2, pa3;
    if constexpr (F32) { VMW(); SWRITE_VF(0); SBAR(); } else { SWRITE_HV(0); SBAR(); }
    if (NT > 1) { if constexpr (F32) SLOAD_F((const float*)Kh, KBASE(1)); else { SLOAD_H(Kh, Vh, Fh, KBASE(1)); BLOAD(Fh, KBASE(1), 1); } }
    SBAR(); qkt<0, SK>(pA0, pA1, K_lds, B_lds, r32, hi, S.qr, ACT(0));
    if constexpr (F32) { if (NT > 1) { VMW(); SWRITE_KF(1); SBAR(); SLOAD_F((const float*)Vh, KBASE(1)); } }
    MASKT(pA0, pA1, 0); partialSM(pA0, pA1, m_reg, mnA, alA);
    if (NT > 1) { VMW(); if constexpr (F32) { SWRITE_VF(1); SBAR(); if (NT > 2) SLOAD_F((const float*)Kh, KBASE(2)); } else SWRITE_H(1); }
    __syncthreads();
#define HALF_STEP(PX0, PX1, mnX, alX, PY0, PY1, alY, t, KB, VB, SB) do {                                                      \
        SBAR(); qkt<KB, SK>(PX0, PX1, K_lds, B_lds, r32, hi, S.qr, ACT(t));                                             \
        finishSM(PY0, PY1, alY, l_reg, pa0, pa1, pa2, pa3); SBAR();                                                           \
        if ((t) + 1 < NT) { if constexpr (F32) { VMW(); SWRITE_KF(SB); SBAR(); SLOAD_F((const float*)Vh, KBASE((t) + 1)); }  \
                            else { SLOAD_H(Kh, Vh, Fh, KBASE((t) + 1)); BLOAD(Fh, KBASE((t) + 1), SB); } SBAR(); }                                               \
        pv_tile<VB, SK>(o, vb0, pa0, pa1, pa2, pa3, ACT((t) - 1)); MASKT(PX0, PX1, (t)); partialSM(PX0, PX1, m_reg, mnX, alX);                                        \
        __syncthreads();                                                                                                      \
        if ((t) + 1 < NT) { VMW(); if constexpr (F32) { SWRITE_VF(SB); SBAR(); if ((t) + 2 < NT) SLOAD_F((const float*)Kh, KBASE((t) + 2)); } \
                            else { SWRITE_H(SB); } }                                                                          \
        RESC(alX); __syncthreads(); } while (0)
    for (int t = 1; t + 1 < NT; t += 2) {
        HALF_STEP(pB0, pB1, mnB, alB, pA0, pA1, alA, t, 1, 0, 0);
        HALF_STEP(pA0, pA1, mnA, alA, pB0, pB1, alB, t + 1, 0, 1, 1);
    }
    const bool even = (NT & 1) == 0;
    if (even) { SBAR(); qkt<1, SK>(pB0, pB1, K_lds, B_lds, r32, hi, S.qr, ACT(NT - 1)); SBAR(); }
#define QROW(e) (nxt.Q + (size_t)(wid * QBLK + r32) * PITCH + ((e) >> 1) * 16 + hi * 8 + ((e) & 1) * 4)
    if constexpr (F32) { SLOAD_F((const float*)nxt.K, kbn); SBAR();
#pragma unroll
        for (int e = 0; e < 8; ++e) S.tq[e] = *(const f32x4*)QROW(e); }
    else { SLOAD_H(nxt.K, nxt.V, nxt.F, kbn); BLOAD(nxt.F, kbn, 0); SBAR();
#pragma unroll
        for (int d0 = 0; d0 < 8; ++d0) S.qr[d0] = load8<TIn>((const TIn*)((const char*)(nxt.Q + (size_t)(wid * QBLK) * PITCH) + qo0) + d0 * 16); }
    SBAR();
    finishSM(pA0, pA1, alA, l_reg, pa0, pa1, pa2, pa3); SBAR();
    if constexpr (F32) {
#pragma unroll
        for (int e = 8; e < 16; ++e) S.tq[e] = *(const f32x4*)QROW(e); SBAR(); }
#undef QROW
    pv_tile<0, SK>(o, vb0, pa0, pa1, pa2, pa3, ACT(even ? NT - 2 : NT - 1));
    if (even) { MASKT(pB0, pB1, NT - 1); partialSM(pB0, pB1, m_reg, mnB, alB); __syncthreads(); RESC(alB);
        finishSM(pB0, pB1, alB, l_reg, pa0, pa1, pa2, pa3); SBAR(); pv_tile<1, SK>(o, vb0, pa0, pa1, pa2, pa3, ACT(NT - 1)); }
    SBAR(); SEAM_K0();
    if (hi == 0) li_l[r32] = l_reg; asm volatile("s_waitcnt lgkmcnt(0)" ::: "memory");
    float rli[16];
#pragma unroll
    for (int r = 0; r < 16; ++r) rli[r] = __builtin_amdgcn_rcpf(li_l[crow(r, hi)]);
    TOut* Ow = cur.O + (size_t)(wid * QBLK) * PITCH; const unsigned oo0 = (unsigned)(4 * hi * PITCH + r32) * 2u;
#pragma unroll
    for (int r = 0; r < 16; ++r) { const int orow = crow(r, hi);
#pragma unroll
        for (int d0 = 0; d0 < 4; ++d0) { const float v = o[d0][r] * rli[r];
            if constexpr (same_t<TOut, float>::v) { Ow[(size_t)orow * PITCH + d0 * 32 + r32] = v; }
            else { const float vn = __shfl_xor(v, 1);
                   if ((r32 & 1) == 0) *(unsigned*)((char*)(Ow + (size_t)((r & 3) + 8 * (r >> 2)) * PITCH + d0 * 32) + oo0) = cvtpk(v, vn); } } }
    if constexpr (F32) {
#pragma unroll
        for (int d0 = 0; d0 < 8; ++d0) S.qr[d0] = pack8(S.tq[2 * d0], S.tq[2 * d0 + 1]); }
    __syncthreads();
#undef RESC
#undef KBASE
#undef ACT
#undef MASKT
#undef SEAM_K0
#undef HALF_STEP
}
#undef ROW
#undef VMW
#undef VMWN
#undef SLOAD_H
#undef SWRITE_HK
#undef SWRITE_HV
#undef SWRITE_H
#undef SLOAD_F
#undef SWRITE_KF
#undef SWRITE_VF

__host__ __device__ inline int swa_nramp(int nqb, int W, int qoff) { const int t = W - 1 - qoff; const int n = t < 0 ? 0 : t / QB + 1; return n > nqb ? nqb : n; }
__host__ __device__ inline int swa_nx(int nqb, int nramp, int order) { return (order & ORDER_PAIRED) ? (nramp + 1) / 2 + (nqb - nramp) : nqb; }
struct SwaItem { int bh, qb0, qb1; };
__device__ __forceinline__ SwaItem swa_decode(int L, int nb, int nh, int nhkv, int nqb, int nx, int nramp, int order) {
    const int G = nh / nhkv; SwaItem it; int x;
    if ((order & ORDER_XCD) && (nb * nhkv) % 8 == 0) { const int xcd = L & 7, k = L >> 3, per = G * nx, gi = k / per, r = k - gi * per;
        it.bh = (gi * 8 + xcd) * G + r / nx; x = r % nx; }
    else { it.bh = L / nx; x = L - it.bh * nx; }
    if (order & ORDER_PAIRED) { const int ns = nqb - nramp;
        if (x < ns) { it.qb0 = it.qb1 = nqb - 1 - x; } else { it.qb0 = x - ns; it.qb1 = nramp - 1 - it.qb0; } }
    else { it.qb0 = it.qb1 = ((order & 3) == ORDER_REVERSED) ? nqb - 1 - x : x; }
    return it;
}
#undef SBAR
#undef KSWZ
}
constexpr int NWAVES = 8;
constexpr int BATCH = 2, T = 8192, D = 2048, NH = 16, HD = 128, FF = 5632;
constexpr int M = BATCH * T;
constexpr int NADA = 9 * D;
constexpr int NADA_ALL = 2 * NADA + 2 * D;
constexpr int NKVF = 2 * D + NH;
constexpr float EPS = 1e-6f;
constexpr float INV_SCALE = 11.313708498984761f;

constexpr size_t MiB = 1u << 20;
constexpr size_t WS_CTL = 0, CTL_ZERO_BYTES = 1 * MiB;
constexpr size_t WS_ADA = 1 * MiB;
constexpr size_t WS_LF = 2 * MiB;
constexpr size_t WS_FKR = 3 * MiB;
constexpr size_t WS_WFI = 8 * MiB;
constexpr size_t WS_WFO = 184 * MiB;
constexpr size_t WS_WCI = 272 * MiB;
constexpr size_t WS_WCO = 296 * MiB;
constexpr size_t WS_WQKV = 304 * MiB;
constexpr size_t WS_WO = 328 * MiB;
constexpr size_t WS_H = 336 * MiB;
constexpr size_t WS_HKV = 400 * MiB;
constexpr size_t WS_OVL = 464 * MiB;
constexpr size_t WS_END = 720 * MiB;
static_assert(WS_HKV == WS_H + (size_t)M * D * 2 && WS_OVL == WS_HKV + (size_t)M * D * 2 && WS_OVL + (size_t)M * FF * 2 <= WS_END && WS_WFI + 4 * (size_t)2 * FF * D * 2 == WS_WFO && WS_WFO + 4 * (size_t)D * FF * 2 == WS_WCI, "d_ws map");
constexpr int CW_BAR = 4096;

constexpr int RING_OFF = 0, RING_BYTES = 131072;
constexpr int LDSCTL_OFF = RING_BYTES, MISC_OFF = LDSCTL_OFF + 320;
constexpr int LDS_BYTES = 147456;
static_assert(MISC_OFF + 128 <= LDS_BYTES, "LDS map");
#define GAS __attribute__((address_space(1)))
#define LAS __attribute__((address_space(3)))
typedef unsigned short bf16;
typedef unsigned v4u __attribute__((ext_vector_type(4)));
typedef float f32x4 __attribute__((ext_vector_type(4)));
typedef short bf16x8 __attribute__((ext_vector_type(8)));
typedef GAS unsigned gu32;
typedef GAS unsigned long long gu64;
#define RLX_AGENT __ATOMIC_RELAXED, __HIP_MEMORY_SCOPE_AGENT
#define LDS_WAIT() asm volatile("s_waitcnt lgkmcnt(0)" ::: "memory")
#define VM_WAIT() asm volatile("s_waitcnt vmcnt(0)" ::: "memory")
__device__ __forceinline__ unsigned long long rt() { return __builtin_amdgcn_s_memrealtime(); }
__device__ __forceinline__ unsigned f2bf(float f) { unsigned u = __builtin_bit_cast(unsigned, f); return (u + 0x7fffu + ((u >> 16) & 1u)) >> 16; }
__device__ __forceinline__ unsigned pk2(float lo, float hi) { return f2bf(lo) | (f2bf(hi) << 16); }

#define XB_TMO      128
#define XB_XCNT(j)  (256  + 64 * (j))
#define XB_XSUB(j)  (1280 + 64 * (j))
#define XB_XGEN(j)  (2304 + 64 * (j))
#define XB_TOP      3328
#define XB_TOPGEN   3392
#define XCD_BAR_WORDS 3456
#define XB_SPIN_CAP (1u << 18)

__device__ __forceinline__ unsigned xb_ld(unsigned* p)              { return __hip_atomic_load(p, __ATOMIC_RELAXED, __HIP_MEMORY_SCOPE_AGENT); }
__device__ __forceinline__ unsigned xb_add(unsigned* p, unsigned v) { return __hip_atomic_fetch_add(p, v, __ATOMIC_RELAXED, __HIP_MEMORY_SCOPE_AGENT); }
__device__ __forceinline__ unsigned xb_xcc_id() { return (unsigned)__builtin_amdgcn_s_getreg((3 << 11) | 20) & 0xFu; }
#define XB_SPIN(cond, bar) do { unsigned _sp = 0; while (cond) { __builtin_amdgcn_s_sleep(1); \
    if ((++_sp & 255u) == 0u) { if (xb_ld(&(bar)[XB_TMO])) break; if (_sp > XB_SPIN_CAP) { atomicAdd(&(bar)[XB_TMO], 1u); break; } } } } while (0)

struct XcdBarrier {
    unsigned* bar; unsigned x;
    volatile LAS unsigned* st;
};

__device__ __forceinline__ XcdBarrier xcd_barrier_post(unsigned* bar, volatile LAS unsigned* st) {
    XcdBarrier b; b.bar = bar; b.x = xb_xcc_id(); b.st = st;
    if (threadIdx.x == 0) (void)xb_add(&bar[XB_XCNT(b.x)], 1u);
    return b;
}
__device__ __forceinline__ void xcd_barrier_complete(unsigned* bar, unsigned x, unsigned& nloc, unsigned& nx) {
    const unsigned G = gridDim.x * gridDim.y * gridDim.z;
    unsigned sum, cnt, mine, sp = 0u;
    for (;;) {
        sum = 0u; cnt = 0u; mine = 0u;
#pragma unroll
        for (unsigned j = 0; j < 16; ++j) { const unsigned c = xb_ld(&bar[XB_XCNT(j)]); sum += c; cnt += (c > 0u) ? 1u : 0u; mine = (j == x) ? c : mine; }
        if (sum == G) break;
        __builtin_amdgcn_s_sleep(1);
        if ((++sp & 255u) == 0u) { if (xb_ld(&bar[XB_TMO])) break; if (sp > XB_SPIN_CAP) { atomicAdd(&bar[XB_TMO], 1u); break; } }
    }
    nloc = mine > 0u ? mine : 1u; nx = cnt > 0u ? cnt : 1u;
}

__device__ __forceinline__ void xcd_barrier(const XcdBarrier& b) {
    asm volatile("s_waitcnt vmcnt(0)" ::: "memory");
    __syncthreads();
    if (threadIdx.x == 0) {
        unsigned* bar = b.bar;
        __builtin_amdgcn_s_waitcnt(0);
        unsigned nloc = b.st[0], nx = b.st[1];
        if (nloc == 0u) { xcd_barrier_complete(bar, b.x, nloc, nx); b.st[0] = nloc; b.st[1] = nx; }
        const unsigned old = xb_add(&bar[XB_XSUB(b.x)], 1u);
        const unsigned gen = old / nloc;
        if (old + 1u == (gen + 1u) * nloc) {
            __builtin_amdgcn_fence(__ATOMIC_RELEASE, "agent");
            asm volatile("s_waitcnt vmcnt(0)" ::: "memory");
            const unsigned og = xb_add(&bar[XB_TOP], 1u);
            const unsigned tg = og / nx;
            if (og + 1u == (tg + 1u) * nx) xb_add(&bar[XB_TOPGEN], 1u);
            else XB_SPIN(xb_ld(&bar[XB_TOPGEN]) == tg, bar);
            __builtin_amdgcn_fence(__ATOMIC_ACQUIRE, "agent");
            xb_add(&bar[XB_XGEN(b.x)], 1u);
            asm volatile("s_waitcnt vmcnt(0)" ::: "memory");
        } else {
            XB_SPIN(xb_ld(&bar[XB_XGEN(b.x)]) == gen, bar);
            __builtin_amdgcn_fence(__ATOMIC_ACQUIRE, "agent");
            asm volatile("s_waitcnt vmcnt(0)" ::: "memory");
        }
    }
    __syncthreads();
}
struct Args { const float* in[19]; float* out; unsigned char* ws; };
struct Frame {
    LAS unsigned char* lds;
    volatile LAS unsigned* MISC;
    int wave;
    int vcu, G;
};
#define PHASE_IDS int tid = threadIdx.x; asm volatile("" : "+v"(tid)); const int lane = tid & 63; (void)lane
#define IN_X(A) ((A).in[0])
#define IN_C(A) ((A).in[1])
#define IN_NORM_G(A) ((A).in[2])
#define IN_W_ADA(A) ((A).in[3])
#define IN_B_ADA(A) ((A).in[4])
#define IN_W_FFN_IN(A) ((A).in[5])
#define IN_W_FFN_OUT(A) ((A).in[6])
#define IN_W_CONV_IN(A) ((A).in[7])
#define IN_CONV_W(A) ((A).in[8])
#define IN_CONV_B(A) ((A).in[9])
#define IN_W_CONV_OUT(A) ((A).in[10])
#define IN_KV_NORM_G(A) ((A).in[11])
#define IN_W_ADA_KV(A) ((A).in[12])
#define IN_B_ADA_KV(A) ((A).in[13])
#define IN_W_KVF(A) ((A).in[14])
#define IN_B_FGATE(A) ((A).in[15])
#define IN_W_Q(A) ((A).in[16])
#define IN_W_O(A) ((A).in[17])
#define IN_FINAL_G(A) ((A).in[18])
#define WSF(A, off) ((float*)((A).ws + (off)))
#define WSB(A, off) ((bf16*)((A).ws + (off)))
#define P_ADA(A) WSF(A, WS_ADA)
#define P_LF(A) WSF(A, WS_LF)
#define P_FKR(A) WSF(A, WS_FKR)
#define P_PART(A) WSF(A, WS_OVL)
#define P_WFI(A) WSB(A, WS_WFI)
#define P_WFO(A) WSB(A, WS_WFO)
#define P_WCI(A) WSB(A, WS_WCI)
#define P_WCO(A) WSB(A, WS_WCO)
#define P_WQKV(A) WSB(A, WS_WQKV)
#define P_WO(A) WSB(A, WS_WO)
#define P_H(A) WSB(A, WS_H)
#define P_HID(A) WSB(A, WS_OVL)
#define P_BG(A) WSB(A, WS_OVL)
#define P_U(A) WSB(A, WS_OVL + 64 * MiB)
#define P_Z(A) WSB(A, WS_OVL + 128 * MiB)
#define P_Q(A) WSB(A, WS_OVL)
#define P_K(A) WSB(A, WS_OVL + 64 * MiB)
#define P_V(A) WSB(A, WS_OVL + 128 * MiB)
#define P_O(A) WSB(A, WS_OVL + 192 * MiB)
__device__ __forceinline__ float wave_sum(float v) {
#pragma unroll
    for (int o = 1; o < 64; o <<= 1) v += __shfl_xor(v, o);
    return v;
}
__device__ __forceinline__ float bf2f(unsigned short h) { return __uint_as_float((unsigned)h << 16); }

__device__ __forceinline__ void p0_ada_partials(const Frame& F, const Args& A) {
    PHASE_IDS;
    LAS float* cond = (LAS float*)(F.lds + RING_OFF);
    for (int i = tid; i < 2 * D; i += NWAVES * 64) { const float v = IN_C(A)[i]; cond[i] = v / (1.0f + __expf(-v)); }
    __syncthreads();
    const int gw = F.vcu * NWAVES + F.wave, NGW = F.G * NWAVES;
    constexpr int NCG = NADA_ALL / 256, NKC = D / 64;
    for (int it = gw; it < NCG * NKC; it += NGW) {
        const int cg = it % NCG, kc = it / NCG, n = cg * 256 + 4 * lane;
        const float* W; int ldw, nn;
        if (cg < NADA / 256) { W = IN_W_ADA(A); ldw = NADA; nn = n; } else if (cg < 2 * NADA / 256) { W = IN_W_ADA(A) + (size_t)D * NADA; ldw = NADA; nn = n - NADA; } else { W = IN_W_ADA_KV(A); ldw = 2 * D; nn = n - 2 * NADA; }
        const float* wp = W + (size_t)(kc * 64) * ldw + nn;
        f32x4 a0 = {0.f, 0.f, 0.f, 0.f}, a1 = {0.f, 0.f, 0.f, 0.f};
#pragma unroll 16
        for (int k = 0; k < 64; ++k) { const f32x4 w = *(const GAS f32x4*)(wp + (size_t)k * ldw); const float c0 = cond[kc * 64 + k], c1 = cond[D + kc * 64 + k]; a0 += w * c0; a1 += w * c1; }
        *(GAS f32x4*)(P_PART(A) + (size_t)(kc * 2 + 0) * NADA_ALL + n) = a0;
        *(GAS f32x4*)(P_PART(A) + (size_t)(kc * 2 + 1) * NADA_ALL + n) = a1;
    }
    __syncthreads();
}
__device__ __forceinline__ int dest_row(int n0, int P, int Hw) { if (n0 < P) return n0; int n1 = n0 - P, up = 0; if (n1 >= Hw) { n1 -= Hw; up = 128; } return P + 256 * (n1 >> 7) + up + (n1 & 127); }
__device__ __forceinline__ void p0_transpose_item(const float* W, int ldw, int K, int nblk, bf16* WT, int P, int Hw, LAS float* scr, int item, int lane) {
    const int kb = item / nblk, nb = item % nblk, k0 = 64 * kb, n0 = 32 * nb, r0 = dest_row(n0, P, Hw);
#pragma unroll 8
    for (int i = 0; i < 32; ++i) { const int kk = 2 * i + (lane >> 5); scr[kk * 33 + (lane & 31)] = W[(size_t)(k0 + kk) * ldw + n0 + (lane & 31)]; }
    LDS_WAIT(); asm volatile("" ::: "memory");
    const int c = lane & 7;
#pragma unroll
    for (int j = 0; j < 4; ++j) { const int n = (lane >> 3) + 8 * j; const LAS float* s = scr + (8 * c) * 33 + n;
        v4u o; o.x = pk2(s[0 * 33], s[1 * 33]); o.y = pk2(s[2 * 33], s[3 * 33]); o.z = pk2(s[4 * 33], s[5 * 33]); o.w = pk2(s[6 * 33], s[7 * 33]);
        *(GAS v4u*)(WT + (size_t)(r0 + n) * K + k0 + 8 * c) = o; }
    LDS_WAIT(); asm volatile("" ::: "memory");
}
__device__ __forceinline__ void p0_convert(const Frame& F, const Args& A) {
    PHASE_IDS;
    LAS float* scr = (LAS float*)(F.lds + RING_OFF + F.wave * 16384);
    const int gw = F.vcu * NWAVES + F.wave, NGW = F.G * NWAVES;
    constexpr int I_FI = (D / 64) * (2 * FF / 32), I_FO = (FF / 64) * (D / 32), I_CI = (D / 64) * (3 * D / 32), I_DD = (D / 64) * (D / 32), I_KV = (D / 64) * (2 * D / 32);
    constexpr int NITEMS = 4 * I_FI + 4 * I_FO + I_CI + I_DD + I_DD + I_KV + I_DD;
    for (int it = gw; it < NITEMS; it += NGW) {
        int r = it;
        if (r < 4 * I_FI) { const int i = r / I_FI; r -= i * I_FI; p0_transpose_item(IN_W_FFN_IN(A) + (size_t)i * D * 2 * FF, 2 * FF, D, 2 * FF / 32, P_WFI(A) + (size_t)i * 2 * FF * D, 0, FF, scr, r, lane); continue; } r -= 4 * I_FI;
        if (r < 4 * I_FO) { const int i = r / I_FO; r -= i * I_FO; p0_transpose_item(IN_W_FFN_OUT(A) + (size_t)i * FF * D, D, FF, D / 32, P_WFO(A) + (size_t)i * D * FF, D, 0, scr, r, lane); continue; } r -= 4 * I_FO;
        if (r < I_CI) { p0_transpose_item(IN_W_CONV_IN(A), 3 * D, D, 3 * D / 32, P_WCI(A), D, D, scr, r, lane); continue; } r -= I_CI;
        if (r < I_DD) { p0_transpose_item(IN_W_CONV_OUT(A), D, D, D / 32, P_WCO(A), D, 0, scr, r, lane); continue; } r -= I_DD;
        if (r < I_DD) { p0_transpose_item(IN_W_Q(A), D, D, D / 32, P_WQKV(A), D, 0, scr, r, lane); continue; } r -= I_DD;
        if (r < I_KV) { p0_transpose_item(IN_W_KVF(A), NKVF, D, 2 * D / 32, P_WQKV(A) + (size_t)D * D, 2 * D, 0, scr, r, lane); continue; } r -= I_KV;
        p0_transpose_item(IN_W_O(A), D, D, D / 32, P_WO(A), D, 0, scr, r, lane);
    }
}
__device__ __forceinline__ void p1_ada_reduce(const Frame& F, const Args& A) {
    PHASE_IDS;
    for (int i = F.vcu * NWAVES * 64 + tid; i < 2 * NADA_ALL; i += F.G * NWAVES * 64) {
        const int b = i / NADA_ALL, n = i - b * NADA_ALL;
        float s = (n < 2 * NADA) ? IN_B_ADA(A)[n] : IN_B_ADA_KV(A)[n - 2 * NADA];
#pragma unroll 8
        for (int kc = 0; kc < D / 64; ++kc) s += P_PART(A)[(size_t)(kc * 2 + b) * NADA_ALL + n];
        P_ADA(A)[i] = s;
    }
}
template <bool FINAL>
__device__ __forceinline__ void norm_phase(const Frame& F, const Args& A, const float* xin, const float* g, int ada_off, bf16* hout, float* fout) {
    PHASE_IDS;
    LAS float* ta = (LAS float*)(F.lds + RING_OFF); LAS float* tsh = ta + D;
    for (int rb = F.vcu; rb < M / 64; rb += F.G) {
        const int b = rb / (T / 64);
        for (int i = tid; i < D; i += NWAVES * 64) { const float gg = g[i];
            if (FINAL) { ta[i] = gg; } else { ta[i] = gg * (1.0f + P_ADA(A)[(size_t)b * NADA_ALL + ada_off + D + i]); tsh[i] = P_ADA(A)[(size_t)b * NADA_ALL + ada_off + i]; } }
        __syncthreads();
#pragma unroll 1
        for (int it = 0; it < 4; ++it) {
            asm volatile("" ::: "memory");
            const int r0 = rb * 64 + F.wave * 8 + it * 2;
            f32x4 xv[2][8]; float rs[2];
#pragma unroll
            for (int r = 0; r < 2; ++r) { const GAS f32x4* xr = (const GAS f32x4*)(xin + (size_t)(r0 + r) * D) + lane;
#pragma unroll
                for (int j = 0; j < 8; ++j) xv[r][j] = xr[64 * j]; }
#pragma unroll
            for (int r = 0; r < 2; ++r) { float s = 0.f;
#pragma unroll
                for (int j = 0; j < 8; ++j) s += (xv[r][j].x * xv[r][j].x + xv[r][j].y * xv[r][j].y) + (xv[r][j].z * xv[r][j].z + xv[r][j].w * xv[r][j].w);
                rs[r] = 1.0f / sqrtf(wave_sum(s) * (1.0f / D) + EPS); }
#pragma unroll
            for (int j = 0; j < 8; ++j) { const f32x4 a = *(const LAS f32x4*)(ta + 4 * lane + 256 * j);
                f32x4 sh = {0.f, 0.f, 0.f, 0.f}; if (!FINAL) sh = *(const LAS f32x4*)(tsh + 4 * lane + 256 * j);
#pragma unroll
                for (int r = 0; r < 2; ++r) { const f32x4 v = xv[r][j] * rs[r] * a + sh;
                    if (FINAL) { *((GAS f32x4*)(fout + (size_t)(r0 + r) * D) + lane + 64 * j) = v; }
                    else { *((GAS unsigned long long*)(hout + (size_t)(r0 + r) * D) + lane + 64 * j) = (unsigned long long)pk2(v.x, v.y) | ((unsigned long long)pk2(v.z, v.w) << 32); } } }
        }
        __syncthreads();
    }
}
__device__ __forceinline__ void fox_norm_phase(const Frame& F, const Args& A, const float* xin) {
    PHASE_IDS;
    LAS float* wfT = (LAS float*)(F.lds + RING_OFF);
    for (int cidx = tid; cidx < D; cidx += NWAVES * 64) { const GAS f32x4* src = (const GAS f32x4*)(IN_W_KVF(A) + (size_t)cidx * NKVF + 2 * D);
#pragma unroll
        for (int q = 0; q < 4; ++q) { const f32x4 w = src[q]; wfT[(4 * q + 0) * D + cidx] = w.x; wfT[(4 * q + 1) * D + cidx] = w.y; wfT[(4 * q + 2) * D + cidx] = w.z; wfT[(4 * q + 3) * D + cidx] = w.w; } }
    __syncthreads();
    const float* g1 = IN_NORM_G(A) + (size_t)(1 * 3 + 1) * D; const float* gk = IN_KV_NORM_G(A);
    for (int rb = F.vcu; rb < M / 64; rb += F.G) {
        const int b = rb / (T / 64);
        const float* ada1 = P_ADA(A) + (size_t)b * NADA_ALL + NADA + 3 * D;
        const float* adak = P_ADA(A) + (size_t)b * NADA_ALL + 2 * NADA;
#pragma unroll 1
        for (int it = 0; it < 4; ++it) {
            unsigned lo = (unsigned)lane * 16u; asm volatile("" : "+v"(lo) :: "memory");
            const int r0 = rb * 64 + F.wave * 8 + it * 2;
            const GAS char* x0 = (const GAS char*)(xin + (size_t)r0 * D);
            float rs[2];
            { f32x4 xv[2][8];
#pragma unroll
              for (int r = 0; r < 2; ++r)
#pragma unroll
                  for (int j = 0; j < 8; ++j) xv[r][j] = *(const GAS f32x4*)(x0 + (size_t)r * D * 4 + j * 1024 + lo);
#pragma unroll
              for (int r = 0; r < 2; ++r) { float s = 0.f;
#pragma unroll
                  for (int j = 0; j < 8; ++j) s += (xv[r][j].x * xv[r][j].x + xv[r][j].y * xv[r][j].y) + (xv[r][j].z * xv[r][j].z + xv[r][j].w * xv[r][j].w);
                  rs[r] = 1.0f / sqrtf(wave_sum(s) * (1.0f / D) + EPS); } }
            float acc[32];
#pragma unroll
            for (int i = 0; i < 32; ++i) acc[i] = 0.f;
            GAS char* h0 = (GAS char*)(P_H(A) + (size_t)r0 * D); GAS char* k0p = (GAS char*)(P_H(A) + (size_t)M * D + (size_t)r0 * D);
#pragma unroll 1
            for (int j = 0; j < 8; ++j) {
                const unsigned jo = lo + (unsigned)j * 1024u;
                const f32x4 a1 = *(const GAS f32x4*)((const GAS char*)g1 + jo) * (*(const GAS f32x4*)((const GAS char*)(ada1 + D) + jo) + 1.0f), s1 = *(const GAS f32x4*)((const GAS char*)ada1 + jo);
                const f32x4 a2 = *(const GAS f32x4*)((const GAS char*)gk + jo) * (*(const GAS f32x4*)((const GAS char*)(adak + D) + jo) + 1.0f), s2 = *(const GAS f32x4*)((const GAS char*)adak + jo);
                f32x4 hk[2];
#pragma unroll
                for (int r = 0; r < 2; ++r) { const f32x4 xn = *(const GAS f32x4*)(x0 + (size_t)r * D * 4 + jo) * rs[r]; const f32x4 h1 = xn * a1 + s1; hk[r] = xn * a2 + s2;
                    *(GAS unsigned long long*)(h0 + (size_t)r * D * 2 + (jo >> 1)) = (unsigned long long)pk2(h1.x, h1.y) | ((unsigned long long)pk2(h1.z, h1.w) << 32);
                    *(GAS unsigned long long*)(k0p + (size_t)r * D * 2 + (jo >> 1)) = (unsigned long long)pk2(hk[r].x, hk[r].y) | ((unsigned long long)pk2(hk[r].z, hk[r].w) << 32); }
#pragma unroll
                for (int hh = 0; hh < 16; ++hh) { const f32x4 w = *(const LAS f32x4*)((const LAS char*)wfT + hh * (D * 4) + jo);
#pragma unroll
                    for (int r = 0; r < 2; ++r) acc[r * 16 + hh] += (hk[r].x * w.x + hk[r].y * w.y) + (hk[r].z * w.z + hk[r].w * w.w); } }
#pragma unroll
            for (int s = 0; s < 5; ++s) { const bool up = (lane >> s) & 1;
#pragma unroll
                for (int i = 0; i < (16 >> s); ++i) { const float a = acc[2 * i], bq = acc[2 * i + 1]; const float send = up ? a : bq, keep = up ? bq : a; acc[i] = keep + __shfl_xor(send, 1 << s); } }
            float z = acc[0] + __shfl_xor(acc[0], 32);
            z += IN_B_FGATE(A)[lane & 15];
            const float ls = fminf(z, 0.f) - log1pf(expf(-fabsf(z)));
            if (lane < 32) P_LF(A)[(size_t)(r0 + (lane >> 4)) * NH + (lane & 15)] = ls;
        }
    }
    __syncthreads();
}
__device__ __forceinline__ void scan_seq(const Frame& F, const Args& A, int seq) {
    PHASE_IDS;
    const int b = seq >> 4, h = seq & 15; const float* lf = P_LF(A) + (size_t)b * T * NH + h;
    float v[16]; float run = 0.f; const int s0 = tid * 16;
#pragma unroll
    for (int k = 0; k < 16; ++k) { run += lf[(size_t)(s0 + k) * NH]; v[k] = run; }
    float incl = run;
#pragma unroll
    for (int o = 1; o < 64; o <<= 1) { const float t = __shfl_up(incl, o); if (lane >= o) incl += t; }
    LAS float* wt = (LAS float*)(F.lds + RING_OFF);
    if (lane == 63) wt[F.wave] = incl;
    __syncthreads();
    float pre = incl - run;
    for (int w = 0; w < F.wave; ++w) pre += wt[w];
    float* o = P_FKR(A) + (size_t)seq * T + s0;
#pragma unroll
    for (int k = 0; k < 16; k += 4) { f32x4 q; q.x = -(pre + v[k]) * INV_SCALE; q.y = -(pre + v[k + 1]) * INV_SCALE; q.z = -(pre + v[k + 2]) * INV_SCALE; q.w = -(pre + v[k + 3]) * INV_SCALE; *(GAS f32x4*)(o + k) = q; }
    __syncthreads();
}
__device__ __forceinline__ void conv_phase(const Frame& F, const Args& A) {
    PHASE_IDS;
    const int half = tid >> 8, col = (tid & 255) * 8;
    float w0[8], w1[8], w2[8], cb[8];
#pragma unroll
    for (int e = 0; e < 8; ++e) { w0[e] = IN_CONV_W(A)[col + e]; w1[e] = IN_CONV_W(A)[D + col + e]; w2[e] = IN_CONV_W(A)[2 * D + col + e]; cb[e] = IN_CONV_B(A)[col + e]; }
    for (int rb = F.vcu; rb < M / 64; rb += F.G) {
        const int t0 = rb * 64 + half * 32;
        float um2[8], um1[8];
        if ((t0 & (T - 1)) != 0) { const bf16x8 a = *(const GAS bf16x8*)(P_U(A) + (size_t)(t0 - 2) * D + col), bq = *(const GAS bf16x8*)(P_U(A) + (size_t)(t0 - 1) * D + col);
#pragma unroll
            for (int e = 0; e < 8; ++e) { um2[e] = bf2f((unsigned short)a[e]); um1[e] = bf2f((unsigned short)bq[e]); } }
        else {
#pragma unroll
            for (int e = 0; e < 8; ++e) { um2[e] = 0.f; um1[e] = 0.f; } }
#pragma unroll 4
        for (int i = 0; i < 32; ++i) { const size_t off = (size_t)(t0 + i) * D + col;
            const bf16x8 uu = *(const GAS bf16x8*)(P_U(A) + off), gg = *(const GAS bf16x8*)(P_BG(A) + off);
            float z[8];
#pragma unroll
            for (int e = 0; e < 8; ++e) { const float uc = bf2f((unsigned short)uu[e]); z[e] = bf2f((unsigned short)gg[e]) * (w0[e] * um2[e] + w1[e] * um1[e] + w2[e] * uc + cb[e]); um2[e] = um1[e]; um1[e] = uc; }
            v4u o; o.x = pk2(z[0], z[1]); o.y = pk2(z[2], z[3]); o.z = pk2(z[4], z[5]); o.w = pk2(z[6], z[7]);
            *(GAS v4u*)(P_Z(A) + off) = o; }
    }
}
__device__ __forceinline__ fox::BlockRef<fox::bf16, fox::bf16> fox_ref(const Args& A, const fox::SwaItem& it, int pass) {
    const int qb = pass ? it.qb1 : it.qb0, b = it.bh >> 4, h = it.bh & 15; const size_t rowbase = (size_t)b * T;
    fox::BlockRef<fox::bf16, fox::bf16> r;
    r.Q = P_Q(A) + (rowbase + (size_t)qb * fox::QB) * D + h * HD; r.O = P_O(A) + (rowbase + (size_t)qb * fox::QB) * D + h * HD;
    r.K = P_K(A) + rowbase * D + h * HD; r.V = P_V(A) + rowbase * D + h * HD; r.F = P_FKR(A) + (size_t)it.bh * T; r.P0 = qb * fox::QB;
    return r;
}
#ifndef PHM
#define PHM 0x7fff
#endif
__device__ __forceinline__ void attn_phase(const Frame& F, const Args& A, char* ldsp) {
    using namespace fox;
    constexpr int nqb = SQ / QB, nramp = nqb, order = ORDER_PAIRED | ORDER_XCD, nx = (nramp + 1) / 2, total = nx * B * H;
    const int stride = F.G; int L = blockIdx.x;
    if (L < total) {
        SwaItem it = swa_decode(L, B, H, HKV, nqb, nx, nramp, order); int pass = 0;
        BlockRef<fox::bf16, fox::bf16> cur = fox_ref(A, it, 0);
        Seam<fox::bf16> S;
        causal_swa_prime<fox::bf16, fox::bf16>(cur, WINDOW, ldsp, S);
        for (;;) {
            const bool more_pass = pass == 0 && it.qb1 != it.qb0, more_item = L + stride < total, last = !more_pass && !more_item;
            SwaItem itn = it; int passn = pass + 1, Ln = L;
            if (!more_pass) { passn = 0; Ln = more_item ? L + stride : L; itn = swa_decode(Ln, B, H, HKV, nqb, nx, nramp, order); }
            const BlockRef<fox::bf16, fox::bf16> nxt = last ? cur : fox_ref(A, itn, passn);
            causal_swa_block<fox::bf16, fox::bf16>(cur, nxt, SKV, WINDOW, ldsp, S);
            if (last) break;
            cur = nxt; it = itn; pass = passn; L = Ln;
        }
    }
}
template <int L>
__device__ __forceinline__ void mixout_phase(const Frame& F, const Args& A) {
#if PHM & 1024
    pg8::Gemm g{L == 0 ? P_Z(A) : P_O(A), L == 0 ? P_WCO(A) : P_WO(A), M, D, D}; pg8::StaticOrder S; S.init(M, D, F.G, (int)blockIdx.x);
    pg8::EpiResid E{A.out, A.out, D, P_ADA(A) + (size_t)L * NADA + 5 * D, NADA_ALL, 1.0f};
    pg8::gemm_phase<pg8::EpiResid, pg8::StaticOrder, true, true>(F.lds + RING_OFF, g, S, E);
#endif
}
template <int L, int HALF>
__device__ __forceinline__ void ffn_block(const Frame& F, const Args& A, const XcdBarrier& bar, unsigned char* lds) {
    constexpr int sub = 2 * HALF, wi = L * 2 + HALF;
    const float* xcur = (L == 0 && HALF == 0) ? IN_X(A) : A.out;
#if PHM & 2048
    norm_phase<false>(F, A, xcur, IN_NORM_G(A) + (size_t)(L * 3 + sub) * D, L * NADA + sub * 3 * D, P_H(A), nullptr);
#endif
    xcd_barrier(bar);
#if PHM & 4096
    { pg8::Gemm g{P_H(A), P_WFI(A) + (size_t)wi * 2 * FF * D, M, 2 * FF, D}; pg8::StaticOrder S; S.init(M, 2 * FF, F.G, (int)blockIdx.x);
      pg8::EpiSwiglu E{P_HID(A), FF};
      pg8::gemm_phase<pg8::EpiSwiglu, pg8::StaticOrder, true, true>(F.lds + RING_OFF, g, S, E); }
#endif
    xcd_barrier(bar);
#if PHM & 8192
    { pg8::Gemm g{P_HID(A), P_WFO(A) + (size_t)wi * D * FF, M, D, FF}; pg8::StaticOrder S; S.init(M, D, F.G, (int)blockIdx.x);
      pg8::EpiResid E{xcur, A.out, D, P_ADA(A) + (size_t)L * NADA + (sub * 3 + 2) * D, NADA_ALL, 0.5f};
      pg8::gemm_phase<pg8::EpiResid, pg8::StaticOrder, true, true>(F.lds + RING_OFF, g, S, E); }
#endif
    xcd_barrier(bar);
}
__global__ void __launch_bounds__(NWAVES * 64, 2) fwd_kernel(Args args) {
    extern __shared__ __attribute__((aligned(16))) unsigned char lds[];
    Frame F;
    F.lds = (LAS unsigned char*)lds;
    F.MISC = (volatile LAS unsigned*)(F.lds + MISC_OFF);
    F.wave = __builtin_amdgcn_readfirstlane((int)threadIdx.x >> 6);
    F.G = gridDim.x; { const int bx = blockIdx.x; F.vcu = (F.G % 8 == 0) ? (bx % 8) * (F.G / 8) + bx / 8 : bx; }
    const Args& A = args;
    for (int u = threadIdx.x; u < (LDS_BYTES - LDSCTL_OFF) / 4; u += NWAVES * 64) ((LAS unsigned*)(F.lds + LDSCTL_OFF))[u] = 0u;
    __syncthreads();
    XcdBarrier bar = xcd_barrier_post((unsigned*)(A.ws + WS_CTL) + CW_BAR, F.MISC + 8);
#define GRID_BAR() xcd_barrier(bar)

#if PHM & 1
    p0_ada_partials(F, A);
#endif
#if PHM & 2
    p0_convert(F, A);
#endif
    GRID_BAR();
#if PHM & 4
    p1_ada_reduce(F, A);
#endif
    GRID_BAR();

    ffn_block<0, 0>(F, A, bar, lds);
#if PHM & 8
    norm_phase<false>(F, A, A.out, IN_NORM_G(A) + (size_t)(0 * 3 + 1) * D, 0 * NADA + 3 * D, P_H(A), nullptr);
#endif
    GRID_BAR();
#if PHM & 16
    { pg8::Gemm g{P_H(A), P_WCI(A), M, 3 * D, D}; pg8::StaticOrder S; S.init(M, 3 * D, F.G, (int)blockIdx.x);
      pg8::EpiConvIn E{P_BG(A), P_U(A), D};
      pg8::gemm_phase<pg8::EpiConvIn, pg8::StaticOrder, true, true>(F.lds + RING_OFF, g, S, E); }
#endif
    GRID_BAR();
#if PHM & 32
    conv_phase(F, A);
#endif
    GRID_BAR();
    mixout_phase<0>(F, A);
    GRID_BAR();
    ffn_block<0, 1>(F, A, bar, lds);
    ffn_block<1, 0>(F, A, bar, lds);
#if PHM & 64
    fox_norm_phase(F, A, A.out);
#endif
    GRID_BAR();
#if PHM & 128
    if (F.vcu < BATCH * NH) scan_seq(F, A, F.vcu);
#endif
#if PHM & 256
    { pg8::Gemm g{P_H(A), P_WQKV(A), 2 * M, 3 * D, D}; pg8::QkvOrder S; S.init(M, 3 * D, F.G, (int)blockIdx.x);
      pg8::EpiQKV E{P_Q(A), (size_t)64 * MiB / 2, D};
      pg8::gemm_phase<pg8::EpiQKV, pg8::QkvOrder, true, true>(F.lds + RING_OFF, g, S, E); }
#endif
    GRID_BAR();
#if PHM & 512
    attn_phase(F, A, (char*)lds + RING_OFF);
#endif
    GRID_BAR();
    mixout_phase<1>(F, A);
    GRID_BAR();
    ffn_block<1, 1>(F, A, bar, lds);
#if PHM & 16384
    norm_phase<true>(F, A, A.out, IN_FINAL_G(A), 0, nullptr, A.out);
#endif
#undef GRID_BAR
}

extern "C" void kernel_launch(void* const* d_in, const int* in_sizes, int n_in, void* d_out, int out_size, void* d_ws, size_t ws_size, hipStream_t stream) {
    static int grid = 0;
    if (grid == 0) {
        if (n_in != 19 || in_sizes[0] != M * D || out_size != M * D || ws_size < WS_END) { fprintf(stderr, "kernel_launch: built for 19 inputs, x and out of %d floats, >= %zu bytes of workspace; got n_in %d, in0 %d, out %d, ws %zu; nothing launched\n", M * D, (size_t)WS_END, n_in, n_in > 0 ? in_sizes[0] : -1, out_size, ws_size); grid = -1; return; }
        int dev = 0, cus = 0, per_cu = 0;
        if (hipGetDevice(&dev) != hipSuccess || hipDeviceGetAttribute(&cus, hipDeviceAttributeMultiprocessorCount, dev) != hipSuccess) { fprintf(stderr, "kernel_launch: hipGetDevice / hipDeviceGetAttribute failed; nothing launched\n"); grid = -1; return; }
        if (hipFuncSetAttribute((const void*)fwd_kernel, hipFuncAttributeMaxDynamicSharedMemorySize, LDS_BYTES) != hipSuccess) { fprintf(stderr, "kernel_launch: hipFuncSetAttribute failed (%d bytes of dynamic LDS); nothing launched\n", LDS_BYTES); grid = -1; return; }
        if (hipOccupancyMaxActiveBlocksPerMultiprocessor(&per_cu, (const void*)fwd_kernel, NWAVES * 64, LDS_BYTES) != hipSuccess || per_cu < 1)
            fprintf(stderr, "kernel_launch: note: the occupancy query reports %d workgroups per CU\n", per_cu);
        (void)hipGetLastError();
        grid = cus;
    }
    if (grid < 0) return;
    if (hipMemsetAsync((char*)d_ws + WS_CTL, 0, CTL_ZERO_BYTES, stream) != hipSuccess) { fprintf(stderr, "kernel_launch: hipMemsetAsync of the control words failed; nothing launched\n"); return; }
    Args a{};
    for (int i = 0; i < 19; ++i) a.in[i] = (const float*)d_in[i];
    a.out = (float*)d_out; a.ws = (unsigned char*)d_ws;
    hipLaunchKernelGGL(fwd_kernel, dim3(grid), dim3(NWAVES * 64), LDS_BYTES, stream, a);
    const hipError_t le = hipPeekAtLastError();
    if (le != hipSuccess) fprintf(stderr, "kernel_launch: launch failed: %s (grid %d x %d threads, %d B LDS)\n", hipGetErrorName(le), grid, NWAVES * 64, LDS_BYTES);
}
```

```cpp
#include <hip/hip_runtime.h>
#include <cstdio>
#include <cstdint>

namespace pg8 {
#define PG8_LAS __attribute__((address_space(3)))
typedef unsigned short bf16_t;
typedef short bf16x8 __attribute__((ext_vector_type(8)));
typedef float f32x4 __attribute__((ext_vector_type(4)));
typedef unsigned u32x4 __attribute__((ext_vector_type(4)));
constexpr int BM = 256, BK = 64, HALF = 128, HTB = HALF * BK * 2  , STAGE_BYTES = 8 * HTB, NXCD = 8, WGM = 8;

__host__ __device__ __forceinline__ int lds_byte(int r, int c) { const int st = (r >> 4) * 2 + (c >> 5), rr = r & 15, cc = c & 31, ob = rr * 64 + cc * 2; return st * 1024 + (ob ^ (((ob >> 9) & 1) << 5)); }
__host__ __device__ __forceinline__ void stage_rc(int b, int& R, int& C) { const int st = b / 1024, sb = b % 1024, swz = sb ^ (((sb >> 9) & 1) << 5); R = (st >> 1) * 16 + swz / 64; C = (st & 1) * 32 + (swz % 64) / 2; }
__host__ __device__ __forceinline__ int perm32(int rho) { const int n = rho >> 4, i = rho & 15; return 8 * (i >> 2) + 4 * n + (i & 3); }

struct Unit { int pm, pn; };
struct Gemm { const bf16_t* A; const bf16_t* Bt; int M, N, K; };

struct StaticOrder {
    int nM, nN, nwg, G, c;
    __host__ __device__ void init(int M, int N, int G_, int c_) { nM = M / BM; nN = N / BM; nwg = nM * nN; G = G_; c = c_; }
    __host__ __device__ bool next(int i, Unit& u) const {
        const long L = (long)i * G + c; if (L >= nwg) return false;
        int wgid = (int)L; { const int q = nwg / NXCD, r = nwg % NXCD, xcd = wgid % NXCD, off = wgid / NXCD; wgid = (xcd < r ? xcd * (q + 1) : r * (q + 1) + (xcd - r) * q) + off; }
        const int nig = WGM * nN, gid = wgid / nig, fm = gid * WGM, gsz = (nM - fm) < WGM ? (nM - fm) : WGM;
        u.pm = fm + ((wgid % nig) % gsz); u.pn = (wgid % nig) / gsz; return true;
    }
    __device__ __forceinline__ void a_ready(const Unit&) const {}
    __device__ __forceinline__ void done(const Unit&) const {}
};

__device__ __forceinline__ unsigned cvt_pk_bf16(float lo, float hi) { unsigned r; asm volatile("v_cvt_pk_bf16_f32 %0, %1, %2" : "=v"(r) : "v"(lo), "v"(hi)); return r; }
__device__ __forceinline__ float silu_f(float a) { return a * __builtin_amdgcn_rcpf(1.0f + __builtin_amdgcn_exp2f(a * -1.4426950408889634f)); }
__device__ __forceinline__ u32x4 pack8_bf16(const f32x4& v0, const f32x4& v1) { u32x4 w; w.x = cvt_pk_bf16(v0[0], v0[1]); w.y = cvt_pk_bf16(v0[2], v0[3]); w.z = cvt_pk_bf16(v1[0], v1[1]); w.w = cvt_pk_bf16(v1[2], v1[3]); return w; }

struct EpiSwiglu {
    static constexpr bool PERM = true, AFTER_DRAIN = false;
    bf16_t* O; int ldc;
    __device__ __forceinline__ void operator()(const f32x4 (&acc)[2][2][4][2], const Unit& u, int wr, int wc, int fr, int fq) const {
        const int row0 = u.pm * BM + wr * 64 + fr, col0 = u.pn * HALF + wc * 32 + 8 * fq;
#pragma unroll
        for (int ai = 0; ai < 2; ++ai)
#pragma unroll
            for (int m = 0; m < 4; ++m) { bf16_t* rowp = O + (size_t)(row0 + ai * HALF + m * 16) * ldc + col0;
                f32x4 v0, v1;
#pragma unroll
                for (int j = 0; j < 4; ++j) { v0[j] = silu_f(acc[ai][0][m][0][j]) * acc[ai][1][m][0][j]; v1[j] = silu_f(acc[ai][0][m][1][j]) * acc[ai][1][m][1][j]; }
                *(u32x4*)rowp = pack8_bf16(v0, v1); }
    }
};
struct EpiConvIn {
    static constexpr bool PERM = true, AFTER_DRAIN = false;
    bf16_t* BG; bf16_t* U; int ldc;
    __device__ __forceinline__ void operator()(const f32x4 (&acc)[2][2][4][2], const Unit& u, int wr, int wc, int fr, int fq) const {
        const int row0 = u.pm * BM + wr * 64 + fr;
        if (u.pn < 8) {
            const int col0 = u.pn * BM + wc * 32 + 8 * fq;
#pragma unroll
            for (int ai = 0; ai < 2; ++ai)
#pragma unroll
                for (int m = 0; m < 4; ++m) { bf16_t* rowp = BG + (size_t)(row0 + ai * HALF + m * 16) * ldc + col0;
#pragma unroll
                    for (int bj = 0; bj < 2; ++bj) *(u32x4*)(rowp + bj * HALF) = pack8_bf16(acc[ai][bj][m][0], acc[ai][bj][m][1]); }
        } else {
            const int col0 = (u.pn - 8) * HALF + wc * 32 + 8 * fq;
#pragma unroll
            for (int ai = 0; ai < 2; ++ai)
#pragma unroll
                for (int m = 0; m < 4; ++m) { bf16_t* rowp = U + (size_t)(row0 + ai * HALF + m * 16) * ldc + col0;
                    const f32x4 v0 = acc[ai][0][m][0] * acc[ai][1][m][0], v1 = acc[ai][0][m][1] * acc[ai][1][m][1];
                    *(u32x4*)rowp = pack8_bf16(v0, v1); }
        }
    }
};
struct EpiQKV {
    static constexpr bool PERM = true, AFTER_DRAIN = false;
    bf16_t* O; size_t stride; int ldc;
    __device__ __forceinline__ void operator()(const f32x4 (&acc)[2][2][4][2], const Unit& u, int wr, int wc, int fr, int fq) const {
        const int row0 = (u.pm & 63) * BM + wr * 64 + fr, col0 = (u.pn & 7) * BM + wc * 32 + 8 * fq; bf16_t* base = O + (size_t)(u.pn >> 3) * stride;
#pragma unroll
        for (int ai = 0; ai < 2; ++ai)
#pragma unroll
            for (int m = 0; m < 4; ++m) { bf16_t* rowp = base + (size_t)(row0 + ai * HALF + m * 16) * ldc + col0;
#pragma unroll
                for (int bj = 0; bj < 2; ++bj) *(u32x4*)(rowp + bj * HALF) = pack8_bf16(acc[ai][bj][m][0], acc[ai][bj][m][1]); }
    }
};
__device__ __forceinline__ void unpack8_bf16(const u32x4& w, f32x4& v0, f32x4& v1) {
    v0[0] = __uint_as_float(w.x << 16); v0[1] = __uint_as_float(w.x & 0xffff0000u); v0[2] = __uint_as_float(w.y << 16); v0[3] = __uint_as_float(w.y & 0xffff0000u);
    v1[0] = __uint_as_float(w.z << 16); v1[1] = __uint_as_float(w.z & 0xffff0000u); v1[2] = __uint_as_float(w.w << 16); v1[3] = __uint_as_float(w.w & 0xffff0000u); }
template <bool BASE_F32> struct EpiResid {
    static constexpr bool PERM = true, AFTER_DRAIN = false;
    const void* base; bf16_t* out; int ldc; const float* gate; int gstride; float sc;
    __device__ __forceinline__ void operator()(const f32x4 (&acc)[2][2][4][2], const Unit& u, int wr, int wc, int fr, int fq) const {
        const int col0 = u.pn * BM + wc * 32 + 8 * fq; const float* gv = gate + (size_t)(u.pm >> 5) * gstride + col0;
#pragma unroll
        for (int bj = 0; bj < 2; ++bj) { const f32x4 g0 = *(const f32x4*)(gv + bj * HALF) * sc, g1 = *(const f32x4*)(gv + bj * HALF + 4) * sc;
#pragma unroll
            for (int ai = 0; ai < 2; ++ai)
#pragma unroll
                for (int m = 0; m < 4; ++m) { const size_t off = (size_t)(u.pm * BM + ai * HALF + wr * 64 + m * 16 + fr) * ldc + col0 + bj * HALF;
                    f32x4 b0, b1;
                    if (BASE_F32) { b0 = *(const f32x4*)((const float*)base + off); b1 = *(const f32x4*)((const float*)base + off + 4); }
                    else unpack8_bf16(*(const u32x4*)((const bf16_t*)base + off), b0, b1);
                    *(u32x4*)(out + off) = pack8_bf16(b0 + g0 * acc[ai][bj][m][0], b1 + g1 * acc[ai][bj][m][1]); } }
    }
};
struct QkvOrder : StaticOrder {
    __device__ __forceinline__ bool next(int i, Unit& u) const { if (!StaticOrder::next(i, u)) return false; if (u.pn >= 8) u.pm += 64; return true; }
};
#ifndef GEMM_PRIO
#define GEMM_PRIO 1
#endif
template <class Epi, class Sched, bool ALIGN_EPI = false, bool SP2 = false, int PV = 0  >
__device__ __forceinline__ void gemm_phase(PG8_LAS unsigned char* lds, const Gemm g, const Sched& S, const Epi& E) {
    int tid_ = threadIdx.x; asm volatile("" : "+v"(tid_));
    const int tid = tid_, wid = __builtin_amdgcn_readfirstlane(tid >> 6), lane = tid & 63, wr = wid >> 2, wc = wid & 3, fr = lane & 15, fq = lane >> 4;
    const int K = g.K, nt = K / BK;
    unsigned voffA[2], voffB[2];
#pragma unroll
    for (int i = 0; i < 2; ++i) { int R, C; stage_rc(tid * 16 + i * 8192, R, C); const int Rb = Epi::PERM ? ((R & ~31) + perm32(R & 31)) : R;
        voffA[i] = (unsigned)(R * K + C) * 2u; voffB[i] = (unsigned)(Rb * K + C) * 2u; }
    const size_t kstep = (size_t)(BK * 2);
    const size_t hstep = (size_t)HALF * K * 2;
    const size_t tstep = 2 * hstep;
    const unsigned ldsw = (unsigned)wid * 1024u;
    const int aoff = lds_byte(wr * 64 + fr, fq * 8), boff = lds_byte(wc * 32 + fr, fq * 8);
#define PG8_SA(b, h) (((b) * 2 + (h)) * HTB)
#define PG8_SB(b, h) ((4 + (b) * 2 + (h)) * HTB)
#define PG8_STAGE(bufoff, gbase, voff) do { _Pragma("unroll") for (int _i = 0; _i < 2; ++_i) if (PV != 3 || staging_on) \
        __builtin_amdgcn_global_load_lds((const unsigned*)((const char*)(gbase) + (voff)[_i]), (PG8_LAS unsigned*)(lds + (bufoff) + ldsw + _i * 8192), 16, 0, 0); } while (0)
#define PG8_LDA(dst, b, h) do { _Pragma("unroll") for (int m = 0; m < (PV == 2 ? 2 : 4); ++m) _Pragma("unroll") for (int k = 0; k < 2; ++k) dst[m][k] = *(const PG8_LAS bf16x8*)(lds + PG8_SA(b, h) + aoff + m * 2048 + k * 1024); } while (0)
#define PG8_LDB(dst, b, h) do { _Pragma("unroll") for (int n = 0; n < 2; ++n) _Pragma("unroll") for (int k = 0; k < 2; ++k) dst[n][k] = *(const PG8_LAS bf16x8*)(lds + PG8_SB(b, h) + boff + n * 2048 + k * 1024); } while (0)
#define PG8_MMA(ai, bj, At, Bt) do { if (GEMM_PRIO) __builtin_amdgcn_s_setprio(1); _Pragma("unroll") for (int m = 0; m < (PV == 1 ? 2 : 4); ++m) _Pragma("unroll") for (int n = 0; n < 2; ++n) _Pragma("unroll") for (int k = 0; k < 2; ++k) \
        acc[ai][bj][m][n] = __builtin_amdgcn_mfma_f32_16x16x32_bf16(Bt[n][k], At[m][k], acc[ai][bj][m][n], 0, 0, 0); if (GEMM_PRIO) __builtin_amdgcn_s_setprio(0); } while (0)
#define PG8_WAIT_V(n) asm volatile("s_waitcnt vmcnt(" #n ")" ::: "memory")
#define PG8_WAIT_L(n) asm volatile("s_waitcnt lgkmcnt(" #n ")" ::: "memory")
#define PG8_BAR __builtin_amdgcn_s_barrier()
#define PG8_SCHED __builtin_amdgcn_sched_barrier(0)
    Unit cur, nxt; int ui = 0; bool staging_on = true; (void)staging_on;
    if (!S.next(0, cur)) return;
    f32x4 acc[2][2][4][2];
#pragma unroll
    for (int a = 0; a < 2; ++a)
#pragma unroll
        for (int b = 0; b < 2; ++b)
#pragma unroll
            for (int m = 0; m < 4; ++m)
#pragma unroll
                for (int n = 0; n < 2; ++n) acc[a][b][m][n] = (f32x4){0.f, 0.f, 0.f, 0.f};
    bf16x8 At[4][2], B0[2][2], B1[2][2];
    const char* cA = (const char*)g.A + (size_t)cur.pm * tstep; const char* cB = (const char*)g.Bt + (size_t)cur.pn * tstep;
    S.a_ready(cur);
    if constexpr (SP2) {
        PG8_STAGE(PG8_SB(0, 0), cB, voffB); PG8_STAGE(PG8_SB(0, 1), cB + hstep, voffB); PG8_STAGE(PG8_SA(0, 0), cA, voffA); PG8_STAGE(PG8_SA(0, 1), cA + hstep, voffA);
        if (wr == 1) PG8_BAR;
        PG8_WAIT_V(2); PG8_BAR;
        PG8_STAGE(PG8_SB(1, 0), cB + kstep, voffB); PG8_STAGE(PG8_SA(1, 0), cA + kstep, voffA); PG8_STAGE(PG8_SB(1, 1), cB + hstep + kstep, voffB);
        PG8_WAIT_V(6); PG8_BAR;
    } else {
        PG8_STAGE(PG8_SB(0, 0), cB, voffB); PG8_STAGE(PG8_SA(0, 0), cA, voffA); PG8_STAGE(PG8_SB(0, 1), cB + hstep, voffB); PG8_STAGE(PG8_SA(0, 1), cA + hstep, voffA);
        if (wr == 1) PG8_BAR;
        PG8_WAIT_V(4); PG8_BAR;
        PG8_STAGE(PG8_SB(1, 0), cB + kstep, voffB); PG8_STAGE(PG8_SA(1, 0), cA + kstep, voffA); PG8_STAGE(PG8_SB(1, 1), cB + hstep + kstep, voffB);
        PG8_WAIT_V(6); PG8_BAR;
    }
    if (PV == 3) staging_on = false;
    for (;;) {
        const bool has_next = S.next(ui + 1, nxt);
        const char* nA = has_next ? (const char*)g.A + (size_t)nxt.pm * tstep : cA; const char* nB = has_next ? (const char*)g.Bt + (size_t)nxt.pn * tstep : cB;
        for (int t = 0; t < nt; t += 2) {
            const bool last = (t == nt - 2);
            const char* a1 = cA + (size_t)(t + 1) * kstep;
            const char* a2 = last ? nA : cA + (size_t)(t + 2) * kstep; const char* b2 = last ? nB : cB + (size_t)(t + 2) * kstep;
            const char* a3 = a2 + kstep; const char* b3 = b2 + kstep;
            if (last && has_next) S.a_ready(nxt);
            if constexpr (SP2) {
            PG8_LDB(B0, 0, 0); PG8_LDB(B1, 0, 1); PG8_SCHED; PG8_LDA(At, 0, 0); PG8_STAGE(PG8_SA(1, 1), a1 + hstep, voffA);
            PG8_WAIT_V(8); PG8_WAIT_L(0); PG8_BAR; PG8_MMA(0, 0, At, B0); PG8_MMA(0, 1, At, B1); PG8_BAR; PG8_SCHED;
            PG8_LDA(At, 0, 1); PG8_STAGE(PG8_SB(0, 0), b2, voffB); PG8_STAGE(PG8_SB(0, 1), b2 + hstep, voffB); PG8_STAGE(PG8_SA(0, 0), a2, voffA);
            PG8_WAIT_V(8); PG8_WAIT_L(0); PG8_BAR; PG8_MMA(1, 0, At, B0); PG8_MMA(1, 1, At, B1); PG8_BAR; PG8_SCHED;
            PG8_LDB(B0, 1, 0); PG8_LDB(B1, 1, 1); PG8_SCHED; PG8_LDA(At, 1, 0); PG8_STAGE(PG8_SA(0, 1), a2 + hstep, voffA);
            PG8_WAIT_V(8); PG8_WAIT_L(0); PG8_BAR; PG8_MMA(0, 0, At, B0); PG8_MMA(0, 1, At, B1); PG8_BAR; PG8_SCHED;
            PG8_LDA(At, 1, 1); PG8_STAGE(PG8_SB(1, 0), b3, voffB); PG8_STAGE(PG8_SB(1, 1), b3 + hstep, voffB); PG8_STAGE(PG8_SA(1, 0), a3, voffA);
            PG8_WAIT_V(8); PG8_WAIT_L(0); PG8_BAR; PG8_MMA(1, 0, At, B0); PG8_MMA(1, 1, At, B1); PG8_BAR; PG8_SCHED;
            } else {
            PG8_LDB(B0, 0, 0); PG8_SCHED; PG8_LDA(At, 0, 0); PG8_STAGE(PG8_SA(1, 1), a1 + hstep, voffA);
            PG8_WAIT_L(8); PG8_BAR; PG8_WAIT_L(0); PG8_MMA(0, 0, At, B0); PG8_BAR; PG8_SCHED;
            PG8_LDB(B1, 0, 1); PG8_STAGE(PG8_SB(0, 0), b2, voffB);
            PG8_BAR; PG8_WAIT_L(0); PG8_MMA(0, 1, At, B1); PG8_BAR;
            PG8_LDA(At, 0, 1); PG8_STAGE(PG8_SA(0, 0), a2, voffA);
            PG8_BAR; PG8_WAIT_L(0); PG8_MMA(1, 0, At, B0); PG8_BAR; PG8_SCHED;
            PG8_STAGE(PG8_SB(0, 1), b2 + hstep, voffB);
            PG8_WAIT_V(6); PG8_BAR; PG8_MMA(1, 1, At, B1); PG8_BAR;
            PG8_LDB(B0, 1, 0); PG8_SCHED; PG8_LDA(At, 1, 0); PG8_STAGE(PG8_SA(0, 1), a2 + hstep, voffA);
            PG8_WAIT_L(8); PG8_BAR; PG8_WAIT_L(0); PG8_MMA(0, 0, At, B0); PG8_BAR; PG8_SCHED;
            PG8_LDB(B1, 1, 1); PG8_STAGE(PG8_SB(1, 0), b3, voffB);
            PG8_BAR; PG8_WAIT_L(0); PG8_MMA(0, 1, At, B1); PG8_BAR;
            PG8_LDA(At, 1, 1); PG8_STAGE(PG8_SA(1, 0), a3, voffA);
            PG8_BAR; PG8_WAIT_L(0); PG8_MMA(1, 0, At, B0); PG8_BAR; PG8_SCHED;
            PG8_STAGE(PG8_SB(1, 1), b3 + hstep, voffB);
            PG8_WAIT_V(6); PG8_BAR; PG8_MMA(1, 1, At, B1); PG8_BAR;
            }
        }
        if constexpr (ALIGN_EPI) { if (wr == 0) PG8_BAR; }
        if constexpr (!Epi::AFTER_DRAIN) { E(acc, cur, wr, wc, fr, fq); S.done(cur); }
        if (!has_next) break;
#pragma unroll
        for (int a = 0; a < 2; ++a)
#pragma unroll
            for (int b = 0; b < 2; ++b)
#pragma unroll
                for (int m = 0; m < 4; ++m)
#pragma unroll
                    for (int n = 0; n < 2; ++n) acc[a][b][m][n] = (f32x4){0.f, 0.f, 0.f, 0.f};
        cur = nxt; cA = nA; cB = nB; ++ui;
        if constexpr (ALIGN_EPI) { if (wr == 1) PG8_BAR; }
    }
    PG8_WAIT_V(0);
    if constexpr (!ALIGN_EPI) { if (wr == 0) PG8_BAR; }
    PG8_BAR;
    if constexpr (Epi::AFTER_DRAIN) { E.fused(acc, cur, wr, wc, fr, fq, lds, wid, lane); S.done(cur); }
#undef PG8_SA
#undef PG8_SB
#undef PG8_STAGE
#undef PG8_LDA
#undef PG8_LDB
#undef PG8_MMA
#undef PG8_WAIT_V
#undef PG8_WAIT_L
#undef PG8_BAR
#undef PG8_SCHED
}
}
namespace fox {
enum { ORDER_NATURAL = 0, ORDER_REVERSED = 1, ORDER_PAIRED = 2, ORDER_XCD = 4 };
constexpr int B = 2, H = 16, HKV = 16, SQ = 8192, SKV = 8192, D = 128, PITCH = 2048;
constexpr int QOFF = 0;
constexpr int WINDOW = 1 << 30;
constexpr float THR = 8.f;
constexpr bool WSKIP = false;
constexpr float SCALE = 0.08838834764831845f;
constexpr int NW = 8, QBLK = 32, KVBLK = 64, QB = NW * QBLK;
constexpr int SHM_V = KVBLK * D * 2, SHM_K = KVBLK * D * 2;
constexpr int BIAS_OFF = 2 * SHM_V + 2 * SHM_K + NW * 64 * 4;
constexpr int LDS_BYTES = BIAS_OFF + 2 * 64 * 4;
static_assert(D == 128 && SQ % QB == 0 && SKV % KVBLK == 0 && H % HKV == 0 && QOFF >= 0 && QOFF + SQ <= SKV && WINDOW >= 1, "geometry");

typedef unsigned short bf16;
typedef short bf16x8 __attribute__((ext_vector_type(8)));
typedef short s16x4 __attribute__((ext_vector_type(4)));
typedef float f32x16 __attribute__((ext_vector_type(16)));
typedef float f32x4 __attribute__((ext_vector_type(4)));
typedef unsigned u32x4 __attribute__((ext_vector_type(4)));
template <class A, class Bt> struct same_t { static constexpr bool v = false; };
template <class A> struct same_t<A, A> { static constexpr bool v = true; };

#define KSWZ(row, colB) ((row) * 256 + ((colB) ^ (((row) & 7) << 4)))
#define SBAR() __builtin_amdgcn_sched_barrier(0)
__device__ __forceinline__ int v_st(int k, int c) { const int kk = (k & ~0xC) | ((k & 4) << 1) | ((k & 8) >> 1); return ((kk >> 3) * 4 + (c >> 5)) * 512 + ((kk & 7) * 32 + (c & 31)) * 2; }
__device__ __forceinline__ int v_rd_base(int lane) { return ((lane & 3) << 3) | (((lane >> 2) & 3) << 6) | (((lane >> 4) & 1) << 5) | (((lane >> 5) & 1) << 8); }
constexpr int v_rd_off(int d0, int ks, int half) { return d0 * 512 + ks * 4096 + half * 2048; }
__device__ __forceinline__ int crow(int r, int hi) { return (r & 3) + 8 * (r >> 2) + 4 * hi; }
__device__ __forceinline__ unsigned cvtpk(float lo, float hi) {
    unsigned r; asm volatile("v_cvt_pk_bf16_f32 %0, %1, %2" : "=v"(r) : "v"(lo), "v"(hi)); return r;
}
__device__ __forceinline__ bf16x8 pack8(f32x4 a, f32x4 b) {
    u32x4 w = {cvtpk(a[0], a[1]), cvtpk(a[2], a[3]), cvtpk(b[0], b[1]), cvtpk(b[2], b[3])};
    return *reinterpret_cast<bf16x8*>(&w);
}
template <class T> __device__ __forceinline__ bf16x8 load8(const T* p) {
    if constexpr (same_t<T, float>::v) { return pack8(*(const f32x4*)p, *(const f32x4*)(p + 4)); }
    else { return *reinterpret_cast<const bf16x8*>(p); }
}
__device__ __forceinline__ void mask_tile(f32x16& p0, f32x16& p1, int dq, unsigned W) {
    const float NEG = -__builtin_inff();
#pragma unroll
    for (int r = 0; r < 16; ++r) {
        const int c = (r & 3) + 8 * (r >> 2);
        if ((unsigned)(dq - c) >= W) p0[r] = NEG;
        if ((unsigned)(dq - c - 32) >= W) p1[r] = NEG;
    }
}
__device__ __forceinline__ void partialSM(f32x16& p0, f32x16& p1, float& m_reg, float& mn, float& alpha) {
    float pmax = p0[0]; for (int r = 1; r < 16; ++r) pmax = fmaxf(pmax, p0[r]); for (int r = 0; r < 16; ++r) pmax = fmaxf(pmax, p1[r]);
    { auto rr = __builtin_amdgcn_permlane32_swap(__float_as_uint(pmax), __float_as_uint(pmax), false, false);
      pmax = fmaxf(__uint_as_float(rr[0]), __uint_as_float(rr[1])); }
    constexpr float C2 = 1.4426950408889634f * SCALE;
    if (__builtin_expect(__all((pmax - m_reg) * SCALE <= THR), 1)) { mn = m_reg; alpha = 1.f; }
    else { mn = fmaxf(m_reg, pmax); alpha = __builtin_amdgcn_exp2f((m_reg - mn) * C2); m_reg = mn; }
    const float mnL = -mn * C2;
    for (int r = 0; r < 16; ++r) p0[r] = fmaf(p0[r], C2, mnL); for (int r = 0; r < 16; ++r) p1[r] = fmaf(p1[r], C2, mnL);
    for (int r = 0; r < 16; ++r) p0[r] = __builtin_amdgcn_exp2f(p0[r]);
}
__device__ __forceinline__ void finishSM(f32x16& p0, f32x16& p1, float alpha, float& l_reg, bf16x8& pa0, bf16x8& pa1, bf16x8& pa2, bf16x8& pa3) {
    for (int r = 0; r < 16; ++r) p1[r] = __builtin_amdgcn_exp2f(p1[r]);
    float ps = 0; for (int r = 0; r < 16; ++r) ps += p0[r]; for (int r = 0; r < 16; ++r) ps += p1[r];
    { auto rr = __builtin_amdgcn_permlane32_swap(__float_as_uint(ps), __float_as_uint(ps), false, false);
      ps = __uint_as_float(rr[0]) + __uint_as_float(rr[1]); }
    l_reg = l_reg * alpha + ps;
#define PK4(P, B_, OUT) do { unsigned a0 = cvtpk(P[B_+0], P[B_+1]), a1 = cvtpk(P[B_+2], P[B_+3]);                          \
        unsigned b0 = cvtpk(P[B_+4], P[B_+5]), b1 = cvtpk(P[B_+6], P[B_+7]);                                             \
        auto r0 = __builtin_amdgcn_permlane32_swap(a0, b0, false, false); auto r1 = __builtin_amdgcn_permlane32_swap(a1, b1, false, false); \
        u32x4 w = {r0[0], r1[0], r0[1], r1[1]}; OUT = *reinterpret_cast<bf16x8*>(&w); } while (0)
    PK4(p0, 0, pa0); PK4(p0, 8, pa1); PK4(p1, 0, pa2); PK4(p1, 8, pa3);
#undef PK4
}
template <int KB, bool SK>
__device__ __forceinline__ void qkt(f32x16& p0, f32x16& p1, const char* K_lds, const float* B_lds, int r32, int hi, const bf16x8* qr, bool act) {
    if (SK && !act) { const float NEG = -__builtin_inff();
#pragma unroll
        for (int r = 0; r < 16; ++r) { p0[r] = NEG; p1[r] = NEG; } return; }
    { const float* bb = B_lds + KB * 64 + 4 * hi;
#pragma unroll
      for (int g = 0; g < 4; ++g) { const f32x4 v0 = *(const f32x4*)(bb + 8 * g), v1 = *(const f32x4*)(bb + 32 + 8 * g);
#pragma unroll
        for (int j = 0; j < 4; ++j) { p0[4 * g + j] = v0[j]; p1[4 * g + j] = v1[j]; } } }
    const char* kb[4];
#pragma unroll
    for (int dd = 0; dd < 4; ++dd) kb[dd] = K_lds + KB * SHM_K + KSWZ(r32, (dd * 16 + hi * 8) * 2);
#pragma unroll
    for (int d0 = 0; d0 < 8; ++d0) { const char* a = kb[d0 & 3] + (d0 >> 2) * 128;
        bf16x8 b0 = *reinterpret_cast<const bf16x8*>(a);
        bf16x8 b1 = *reinterpret_cast<const bf16x8*>(a + 32 * 256);
        p0 = __builtin_amdgcn_mfma_f32_32x32x16_bf16(b0, qr[d0], p0, 0, 0, 0);
        p1 = __builtin_amdgcn_mfma_f32_32x32x16_bf16(b1, qr[d0], p1, 0, 0, 0); }
}
template <int VB, bool SK>
__device__ __forceinline__ void pv_tile(f32x16* o, int vb0, bf16x8 pa0, bf16x8 pa1, bf16x8 pa2, bf16x8 pa3, bool act) {
    if (SK && !act) return;
#define TRRD(dst, off) asm volatile("ds_read_b64_tr_b16 %0, %1 offset:%2" : "=&v"(dst) : "v"(vb0), "i"(off) : "memory")
#define PV_D0(d0) do { s16x4 l0, l1, l2, l3, h0, h1, h2, h3; constexpr int b_ = VB * SHM_V + v_rd_off(d0, 0, 0);     \
        TRRD(l0, b_); TRRD(h0, b_ + 2048); TRRD(l1, b_ + 4096); TRRD(h1, b_ + 6144); TRRD(l2, b_ + 8192); TRRD(h2, b_ + 10240); TRRD(l3, b_ + 12288); TRRD(h3, b_ + 14336); \
        asm volatile("s_waitcnt lgkmcnt(0)" ::: "memory"); SBAR();                 \
        o[d0] = __builtin_amdgcn_mfma_f32_32x32x16_bf16(pa0, (bf16x8){l0[0], l0[1], l0[2], l0[3], h0[0], h0[1], h0[2], h0[3]}, o[d0], 0, 0, 0);   \
        o[d0] = __builtin_amdgcn_mfma_f32_32x32x16_bf16(pa1, (bf16x8){l1[0], l1[1], l1[2], l1[3], h1[0], h1[1], h1[2], h1[3]}, o[d0], 0, 0, 0);   \
        o[d0] = __builtin_amdgcn_mfma_f32_32x32x16_bf16(pa2, (bf16x8){l2[0], l2[1], l2[2], l2[3], h2[0], h2[1], h2[2], h2[3]}, o[d0], 0, 0, 0);   \
        o[d0] = __builtin_amdgcn_mfma_f32_32x32x16_bf16(pa3, (bf16x8){l3[0], l3[1], l3[2], l3[3], h3[0], h3[1], h3[2], h3[3]}, o[d0], 0, 0, 0); } while (0)
    PV_D0(0); PV_D0(1); PV_D0(2); PV_D0(3);
#undef PV_D0
#undef TRRD
}

__device__ __forceinline__ void glds4(const float* gbase, unsigned voff, unsigned lds_dst) { unsigned keep;
    asm volatile("s_mov_b32 %0, m0\n\ts_mov_b32 m0, %3\n\ts_nop 0\n\tglobal_load_lds_dword %1, %2\n\ts_mov_b32 m0, %0" : "=&s"(keep) : "v"(voff), "s"(gbase), "s"(lds_dst) : "memory"); }
template <class TIn, class TOut> struct BlockRef { const TIn* Q; const TIn* K; const TIn* V; TOut* O; const float* F; int P0; };
template <class TIn> struct Seam {
    bf16x8 qr[8];
    bf16x8 st_v0, st_v1, st_k0, st_k1; f32x4 sf0, sf1, sf2, sf3;
    f32x4 tq[16];
};
__device__ __forceinline__ int swa_jlo(int P0, int W) { const int lowk = P0 - W + 1; return lowk > 0 ? lowk / KVBLK : 0; }
#define ROW(p, k0, rr) ((p) + (size_t)((k0) + (rr)) * PITCH + sc)
#define ROWU(p, k0, add) ((const TIn*)((const char*)((p) + (size_t)((k0) + (add)) * PITCH) + so0))
#define VMW() asm volatile("s_waitcnt vmcnt(0)" ::: "memory")
#define VMWN(n) asm volatile("s_waitcnt vmcnt(%0)" :: "i"(n) : "memory")
#define SLOAD_H(Kp, Vp, Fp, k0) do { S.st_v0 = load8<TIn>(ROWU(Vp, k0, 0)); S.st_v1 = load8<TIn>(ROWU(Vp, k0, 32));              \
                         S.st_k0 = load8<TIn>(ROWU(Kp, k0, 0)); S.st_k1 = load8<TIn>(ROWU(Kp, k0, 32)); } while (0)
#define SWRITE_HK(bf) do { *(bf16x8*)(K_lds + (bf) * SHM_K + kws) = S.st_k0; *(bf16x8*)(K_lds + (bf) * SHM_K + kws + 32 * 256) = S.st_k1; } while (0)
#define SWRITE_HV(bf) do { *(bf16x8*)(V_lds + (bf) * SHM_V + vst0) = S.st_v0; *(bf16x8*)(V_lds + (bf) * SHM_V + vst1) = S.st_v1; } while (0)
#define SWRITE_H(bf) do { SWRITE_HV(bf); SWRITE_HK(bf); } while (0)
#define BLOAD(Fp, k0, bf) do { if (wid == 0) glds4((Fp) + (k0), (unsigned)(lane * 4), lds_b0 + (bf) * 256); } while (0)
#define SLOAD_F(p, k0) do { S.sf0 = *(const f32x4*)ROW(p, k0, sr); S.sf1 = *(const f32x4*)(ROW(p, k0, sr) + 4);                \
                            S.sf2 = *(const f32x4*)ROW(p, k0, 32 + sr); S.sf3 = *(const f32x4*)(ROW(p, k0, 32 + sr) + 4); } while (0)
#define SWRITE_KF(bf) do { *(bf16x8*)(K_lds + (bf) * SHM_K + kws) = pack8(S.sf0, S.sf1); *(bf16x8*)(K_lds + (bf) * SHM_K + kws + 32 * 256) = pack8(S.sf2, S.sf3); } while (0)
#define SWRITE_VF(bf) do { *(bf16x8*)(V_lds + (bf) * SHM_V + vst0) = pack8(S.sf0, S.sf1); *(bf16x8*)(V_lds + (bf) * SHM_V + vst1) = pack8(S.sf2, S.sf3); } while (0)
template <class TIn, class TOut>
__device__ __forceinline__ void causal_swa_prime(const BlockRef<TIn, TOut>& cur, int W, char* lds, Seam<TIn>& S) {
    constexpr bool F32 = same_t<TIn, float>::v;
    const int tid = threadIdx.x, wid = __builtin_amdgcn_readfirstlane(tid >> 6), lane = tid & 63, r32 = lane & 31, hi = lane >> 5;
    const int sr = tid >> 4, sc = (tid & 15) * 8, kws = KSWZ(sr, sc * 2); const unsigned so0 = (unsigned)(sr * PITCH + sc) * 2u; char* K_lds = lds + 2 * SHM_V; const unsigned lds_b0 = (unsigned)__builtin_amdgcn_readfirstlane((int)(uintptr_t)lds + BIAS_OFF);
    const int kb0 = swa_jlo(cur.P0, W) * KVBLK;
    { const unsigned qo0 = (unsigned)(r32 * PITCH + hi * 8) * 2u; const char* qb_ = (const char*)(cur.Q + (size_t)(wid * QBLK) * PITCH);
      for (int d0 = 0; d0 < 8; ++d0) S.qr[d0] = load8<TIn>((const TIn*)(qb_ + qo0) + d0 * 16); }
    if constexpr (F32) { SLOAD_F((const float*)cur.K, kb0); VMW(); SWRITE_KF(0); SBAR(); SLOAD_F((const float*)cur.V, kb0); }
    else { SLOAD_H(cur.K, cur.V, cur.F, kb0); BLOAD(cur.F, kb0, 0); VMW(); SWRITE_HK(0); }
    __syncthreads();
}
template <class TIn, class TOut>
__device__ __forceinline__ void causal_swa_block(const BlockRef<TIn, TOut>& cur, const BlockRef<TIn, TOut>& nxt, int skv, int W, char* lds, Seam<TIn>& S) {
    constexpr bool F32 = same_t<TIn, float>::v;
    const int tid = threadIdx.x, wid = __builtin_amdgcn_readfirstlane(tid >> 6), lane = tid & 63, r32 = lane & 31, hi = lane >> 5;
    const int j_lo = swa_jlo(cur.P0, W);
    int j_hi = (cur.P0 + QB - 1) / KVBLK + 1; if (j_hi > skv / KVBLK) j_hi = skv / KVBLK;
    const int NT = j_hi - j_lo;
    const int kbn = swa_jlo(nxt.P0, W) * KVBLK;
    const int qlo = cur.P0 + wid * QBLK, qm = qlo + r32 - 4 * hi;
    char* V_lds = lds; char* K_lds = lds + 2 * SHM_V; const float* B_lds = (const float*)(lds + BIAS_OFF); const unsigned lds_b0 = (unsigned)__builtin_amdgcn_readfirstlane((int)(uintptr_t)lds + BIAS_OFF);
    float* ws = (float*)(lds + 2 * SHM_V + 2 * SHM_K) + wid * 64; float* li_l = ws, * al_l = ws + 32;
    float m_reg = -1e30f, l_reg = 0; f32x16 o[4] = {};
    const int sr = tid >> 4, sc = (tid & 15) * 8, vst0 = v_st(sr, sc), vst1 = v_st(32 + sr, sc), kws = KSWZ(sr, sc * 2); const unsigned so0 = (unsigned)(sr * PITCH + sc) * 2u, qo0 = (unsigned)(r32 * PITCH + hi * 8) * 2u;
    const int vb0 = (int)(uintptr_t)V_lds + v_rd_base(lane);
    const TIn* Kh = cur.K; const TIn* Vh = cur.V; const float* Fh = cur.F;
#define RESC(a) do { if (__any((a) < 1.f)) { if (hi == 0) al_l[r32] = (a); asm volatile("s_waitcnt lgkmcnt(0)" ::: "memory");              \
                     for (int d_ = 0; d_ < 4; ++d_) for (int r = 0; r < 16; ++r) o[d_][r] *= al_l[crow(r, hi)]; } } while (0)
#define KBASE(t) ((j_lo + (t)) * KVBLK)
#define ACT(t) (KBASE(t) <= qlo + QBLK - 1 && KBASE(t) + KVBLK - 1 >= qlo - W + 1)
#define MASKT(P0_, P1_, t) do { const int kb_ = KBASE(t); if ((!SK || ACT(t)) && (kb_ + KVBLK - 1 > qlo || kb_ <= qlo + QBLK - 1 - W)) mask_tile(P0_, P1_, qm - kb_, (unsigned)W); } while (0)
    constexpr int NQL = F32 ? 16 : 8;
    constexpr bool SK = WSKIP && !F32;
#define SEAM_K0() do { VMWN(NQL); if constexpr (F32) { SWRITE_KF(0); SBAR(); SLOAD_F((const float*)nxt.V, kbn); } else { SWRITE_HK(0); } SBAR(); } while (0)
    f32x16 pA0, pA1, pB0, pB1; float mnA, mnB, alA, alB; bf16x8 pa0, pa1, pa2, pa3;
    if constexpr (F32) { VMW(); SWRITE_VF(0); SBAR(); } else { SWRITE_HV(0); SBAR(); }
    if (NT > 1) { if constexpr (F32) SLOAD_F((const float*)Kh, KBASE(1)); else { SLOAD_H(Kh, Vh, Fh, KBASE(1)); BLOAD(Fh, KBASE(1), 1); } }
    SBAR(); qkt<0, SK>(pA0, pA1, K_lds, B_lds, r32, hi, S.qr, ACT(0));
    if constexpr (F32) { if (NT > 1) { VMW(); SWRITE_KF(1); SBAR(); SLOAD_F((const float*)Vh, KBASE(1)); } }
    MASKT(pA0, pA1, 0); partialSM(pA0, pA1, m_reg, mnA, alA);
    if (NT > 1) { VMW(); if constexpr (F32) { SWRITE_VF(1); SBAR(); if (NT > 2) SLOAD_F((const float*)Kh, KBASE(2)); } else SWRITE_H(1); }
    __syncthreads();
#define HALF_STEP(PX0, PX1, mnX, alX, PY0, PY1, alY, t, KB, VB, SB) do {                                                      \
        SBAR(); qkt<KB, SK>(PX0, PX1, K_lds, B_lds, r32, hi, S.qr, ACT(t));                                             \
        finishSM(PY0, PY1, alY, l_reg, pa0, pa1, pa2, pa3); SBAR();                                                           \
        if ((t) + 1 < NT) { if constexpr (F32) { VMW(); SWRITE_KF(SB); SBAR(); SLOAD_F((const float*)Vh, KBASE((t) + 1)); }  \
                            else { SLOAD_H(Kh, Vh, Fh, KBASE((t) + 1)); BLOAD(Fh, KBASE((t) + 1), SB); } SBAR(); }                                               \
        pv_tile<VB, SK>(o, vb0, pa0, pa1, pa2, pa3, ACT((t) - 1)); MASKT(PX0, PX1, (t)); partialSM(PX0, PX1, m_reg, mnX, alX);                                        \
        __syncthreads();                                                                                                      \
        if ((t) + 1 < NT) { VMW(); if constexpr (F32) { SWRITE_VF(SB); SBAR(); if ((t) + 2 < NT) SLOAD_F((const float*)Kh, KBASE((t) + 2)); } \
                            else { SWRITE_H(SB); } }                                                                          \
        RESC(alX); __syncthreads(); } while (0)
    for (int t = 1; t + 1 < NT; t += 2) {
        HALF_STEP(pB0, pB1, mnB, alB, pA0, pA1, alA, t, 1, 0, 0);
        HALF_STEP(pA0, pA1, mnA, alA, pB0, pB1, alB, t + 1, 0, 1, 1);
    }
    const bool even = (NT & 1) == 0;
    if (even) { SBAR(); qkt<1, SK>(pB0, pB1, K_lds, B_lds, r32, hi, S.qr, ACT(NT - 1)); SBAR(); }
#define QROW(e) (nxt.Q + (size_t)(wid * QBLK + r32) * PITCH + ((e) >> 1) * 16 + hi * 8 + ((e) & 1) * 4)
    if constexpr (F32) { SLOAD_F((const float*)nxt.K, kbn); SBAR();
#pragma unroll
        for (int e = 0; e < 8; ++e) S.tq[e] = *(const f32x4*)QROW(e); }
    else { SLOAD_H(nxt.K, nxt.V, nxt.F, kbn); BLOAD(nxt.F, kbn, 0); SBAR();
#pragma unroll
        for (int d0 = 0; d0 < 8; ++d0) S.qr[d0] = load8<TIn>((const TIn*)((const char*)(nxt.Q + (size_t)(wid * QBLK) * PITCH) + qo0) + d0 * 16); }
    SBAR();
    finishSM(pA0, pA1, alA, l_reg, pa0, pa1, pa2, pa3); SBAR();
    if constexpr (F32) {
#pragma unroll
        for (int e = 8; e < 16; ++e) S.tq[e] = *(const f32x4*)QROW(e); SBAR(); }
#undef QROW
    pv_tile<0, SK>(o, vb0, pa0, pa1, pa2, pa3, ACT(even ? NT - 2 : NT - 1));
    if (even) { MASKT(pB0, pB1, NT - 1); partialSM(pB0, pB1, m_reg, mnB, alB); __syncthreads(); RESC(alB);
        finishSM(pB0, pB1, alB, l_reg, pa0, pa1, pa2, pa3); SBAR(); pv_tile<1, SK>(o, vb0, pa0, pa1, pa2, pa3, ACT(NT - 1)); }
    SBAR(); SEAM_K0();
    if (hi == 0) li_l[r32] = l_reg; asm volatile("s_waitcnt lgkmcnt(0)" ::: "memory");
    float rli[16];
#pragma unroll
    for (int r = 0; r < 16; ++r) rli[r] = __builtin_amdgcn_rcpf(li_l[crow(r, hi)]);
    TOut* Ow = cur.O + (size_t)(wid * QBLK) * PITCH; const unsigned oo0 = (unsigned)(4 * hi * PITCH + r32) * 2u;
#pragma unroll
    for (int r = 0; r < 16; ++r) { const int orow = crow(r, hi);
#pragma unroll
        for (int d0 = 0; d0 < 4; ++d0) { const float v = o[d0][r] * rli[r];
            if constexpr (same_t<TOut, float>::v) { Ow[(size_t)orow * PITCH + d0 * 32 + r32] = v; }
            else { const float vn = __shfl_xor(v, 1);
                   if ((r32 & 1) == 0) *(unsigned*)((char*)(Ow + (size_t)((r & 3) + 8 * (r >> 2)) * PITCH + d0 * 32) + oo0) = cvtpk(v, vn); } } }
    if constexpr (F32) {
#pragma unroll
        for (int d0 = 0; d0 < 8; ++d0) S.qr[d0] = pack8(S.tq[2 * d0], S.tq[2 * d0 + 1]); }
    __syncthreads();
#undef RESC
#undef KBASE
#undef ACT
#undef MASKT
#undef SEAM_K0
#undef HALF_STEP
}
#undef ROW
#undef VMW
#undef VMWN
#undef SLOAD_H
#undef SWRITE_HK
#undef SWRITE_HV
#undef SWRITE_H
#undef SLOAD_F
#undef SWRITE_KF
#undef SWRITE_VF

__host__ __device__ inline int swa_nramp(int nqb, int W, int qoff) { const int t = W - 1 - qoff; const int n = t < 0 ? 0 : t / QB + 1; return n > nqb ? nqb : n; }
__host__ __device__ inline int swa_nx(int nqb, int nramp, int order) { return (order & ORDER_PAIRED) ? (nramp + 1) / 2 + (nqb - nramp) : nqb; }
struct SwaItem { int bh, qb0, qb1; };
__device__ __forceinline__ SwaItem swa_decode(int L, int nb, int nh, int nhkv, int nqb, int nx, int nramp, int order) {
    const int G = nh / nhkv; SwaItem it; int x;
    if ((order & ORDER_XCD) && (nb * nhkv) % 8 == 0) { const int xcd = L & 7, k = L >> 3, per = G * nx, gi = k / per, r = k - gi * per;
        it.bh = (gi * 8 + xcd) * G + r / nx; x = r % nx; }
    else { it.bh = L / nx; x = L - it.bh * nx; }
    if (order & ORDER_PAIRED) { const int ns = nqb - nramp;
        if (x < ns) { it.qb0 = it.qb1 = nqb - 1 - x; } else { it.qb0 = x - ns; it.qb1 = nramp - 1 - it.qb0; } }
    else { it.qb0 = it.qb1 = ((order & 3) == ORDER_REVERSED) ? nqb - 1 - x : x; }
    return it;
}
#undef SBAR
#undef KSWZ
}
constexpr int NWAVES = 8;
constexpr int BATCH = 2, T = 8192, D = 2048, NH = 16, HD = 128, FF = 5632;
constexpr int M = BATCH * T;
constexpr int NADA = 9 * D;
constexpr int NADA_ALL = 2 * NADA + 2 * D;
constexpr int NKVF = 2 * D + NH;
constexpr float EPS = 1e-6f;
constexpr float INV_SCALE = 11.313708498984761f;

constexpr size_t MiB = 1u << 20;
constexpr size_t WS_CTL = 0, CTL_ZERO_BYTES = 1 * MiB;
constexpr size_t WS_ADA = 1 * MiB;
constexpr size_t WS_LF = 2 * MiB;
constexpr size_t WS_FKR = 3 * MiB;
constexpr size_t WS_WFI = 8 * MiB;
constexpr size_t WS_WFO = 184 * MiB;
constexpr size_t WS_WCI = 272 * MiB;
constexpr size_t WS_WCO = 296 * MiB;
constexpr size_t WS_WQKV = 304 * MiB;
constexpr size_t WS_WO = 328 * MiB;
constexpr size_t WS_H = 336 * MiB;
constexpr size_t WS_HKV = 400 * MiB;
constexpr size_t WS_OVL = 464 * MiB;
constexpr size_t WS_XB = 720 * MiB;
constexpr size_t WS_END = 784 * MiB;
static_assert(WS_HKV == WS_H + (size_t)M * D * 2 && WS_OVL == WS_HKV + (size_t)M * D * 2 && WS_OVL + (size_t)M * FF * 2 <= WS_END && WS_WFI + 4 * (size_t)2 * FF * D * 2 == WS_WFO && WS_WFO + 4 * (size_t)D * FF * 2 == WS_WCI, "d_ws map");
constexpr int CW_BAR = 4096;

constexpr int RING_OFF = 0, RING_BYTES = 131072;
constexpr int LDSCTL_OFF = RING_BYTES, MISC_OFF = LDSCTL_OFF + 320;
constexpr int LDS_BYTES = 147456;
static_assert(MISC_OFF + 128 <= LDS_BYTES, "LDS map");
#define GAS __attribute__((address_space(1)))
#define LAS __attribute__((address_space(3)))
typedef unsigned short bf16;
typedef unsigned v4u __attribute__((ext_vector_type(4)));
typedef float f32x4 __attribute__((ext_vector_type(4)));
typedef short bf16x8 __attribute__((ext_vector_type(8)));
typedef GAS unsigned gu32;
typedef GAS unsigned long long gu64;
#define RLX_AGENT __ATOMIC_RELAXED, __HIP_MEMORY_SCOPE_AGENT
#define LDS_WAIT() asm volatile("s_waitcnt lgkmcnt(0)" ::: "memory")
#define VM_WAIT() asm volatile("s_waitcnt vmcnt(0)" ::: "memory")
__device__ __forceinline__ unsigned long long rt() { return __builtin_amdgcn_s_memrealtime(); }
__device__ __forceinline__ unsigned f2bf(float f) { unsigned u = __builtin_bit_cast(unsigned, f); return (u + 0x7fffu + ((u >> 16) & 1u)) >> 16; }
__device__ __forceinline__ unsigned pk2(float lo, float hi) { return f2bf(lo) | (f2bf(hi) << 16); }

#define XB_TMO      128
#define XB_XCNT(j)  (256  + 64 * (j))
#define XB_XSUB(j)  (1280 + 64 * (j))
#define XB_XGEN(j)  (2304 + 64 * (j))
#define XB_TOP      3328
#define XB_TOPGEN   3392
#define XCD_BAR_WORDS 3456
#define XB_SPIN_CAP (1u << 18)

__device__ __forceinline__ unsigned xb_ld(unsigned* p)              { return __hip_atomic_load(p, __ATOMIC_RELAXED, __HIP_MEMORY_SCOPE_AGENT); }
__device__ __forceinline__ unsigned xb_add(unsigned* p, unsigned v) { return __hip_atomic_fetch_add(p, v, __ATOMIC_RELAXED, __HIP_MEMORY_SCOPE_AGENT); }
__device__ __forceinline__ unsigned xb_xcc_id() { return (unsigned)__builtin_amdgcn_s_getreg((3 << 11) | 20) & 0xFu; }
#define XB_SPIN(cond, bar) do { unsigned _sp = 0; while (cond) { __builtin_amdgcn_s_sleep(1); \
    if ((++_sp & 255u) == 0u) { if (xb_ld(&(bar)[XB_TMO])) break; if (_sp > XB_SPIN_CAP) { atomicAdd(&(bar)[XB_TMO], 1u); break; } } } } while (0)

struct XcdBarrier {
    unsigned* bar; unsigned x;
    volatile LAS unsigned* st;
};

__device__ __forceinline__ XcdBarrier xcd_barrier_post(unsigned* bar, volatile LAS unsigned* st) {
    XcdBarrier b; b.bar = bar; b.x = xb_xcc_id(); b.st = st;
    if (threadIdx.x == 0) (void)xb_add(&bar[XB_XCNT(b.x)], 1u);
    return b;
}
__device__ __forceinline__ void xcd_barrier_complete(unsigned* bar, unsigned x, unsigned& nloc, unsigned& nx) {
    const unsigned G = gridDim.x * gridDim.y * gridDim.z;
    unsigned sum, cnt, mine, sp = 0u;
    for (;;) {
        sum = 0u; cnt = 0u; mine = 0u;
#pragma unroll
        for (unsigned j = 0; j < 16; ++j) { const unsigned c = xb_ld(&bar[XB_XCNT(j)]); sum += c; cnt += (c > 0u) ? 1u : 0u; mine = (j == x) ? c : mine; }
        if (sum == G) break;
        __builtin_amdgcn_s_sleep(1);
        if ((++sp & 255u) == 0u) { if (xb_ld(&bar[XB_TMO])) break; if (sp > XB_SPIN_CAP) { atomicAdd(&bar[XB_TMO], 1u); break; } }
    }
    nloc = mine > 0u ? mine : 1u; nx = cnt > 0u ? cnt : 1u;
}

__device__ __forceinline__ void xcd_barrier(const XcdBarrier& b) {
    asm volatile("s_waitcnt vmcnt(0)" ::: "memory");
    __syncthreads();
    if (threadIdx.x == 0) {
        unsigned* bar = b.bar;
        __builtin_amdgcn_s_waitcnt(0);
        unsigned nloc = b.st[0], nx = b.st[1];
        if (nloc == 0u) { xcd_barrier_complete(bar, b.x, nloc, nx); b.st[0] = nloc; b.st[1] = nx; }
        const unsigned old = xb_add(&bar[XB_XSUB(b.x)], 1u);
        const unsigned gen = old / nloc;
        if (old + 1u == (gen + 1u) * nloc) {
            __builtin_amdgcn_fence(__ATOMIC_RELEASE, "agent");
            asm volatile("s_waitcnt vmcnt(0)" ::: "memory");
            const unsigned og = xb_add(&bar[XB_TOP], 1u);
            const unsigned tg = og / nx;
            if (og + 1u == (tg + 1u) * nx) xb_add(&bar[XB_TOPGEN], 1u);
            else XB_SPIN(xb_ld(&bar[XB_TOPGEN]) == tg, bar);
            __builtin_amdgcn_fence(__ATOMIC_ACQUIRE, "agent");
            xb_add(&bar[XB_XGEN(b.x)], 1u);
            asm volatile("s_waitcnt vmcnt(0)" ::: "memory");
        } else {
            XB_SPIN(xb_ld(&bar[XB_XGEN(b.x)]) == gen, bar);
            __builtin_amdgcn_fence(__ATOMIC_ACQUIRE, "agent");
            asm volatile("s_waitcnt vmcnt(0)" ::: "memory");
        }
    }
    __syncthreads();
}
struct Args { const float* in[19]; float* out; unsigned char* ws; };
struct Frame {
    LAS unsigned char* lds;
    volatile LAS unsigned* MISC;
    int wave;
    int vcu, G;
};
#define PHASE_IDS int tid = threadIdx.x; asm volatile("" : "+v"(tid)); const int lane = tid & 63; (void)lane
#define IN_X(A) ((A).in[0])
#define IN_C(A) ((A).in[1])
#define IN_NORM_G(A) ((A).in[2])
#define IN_W_ADA(A) ((A).in[3])
#define IN_B_ADA(A) ((A).in[4])
#define IN_W_FFN_IN(A) ((A).in[5])
#define IN_W_FFN_OUT(A) ((A).in[6])
#define IN_W_CONV_IN(A) ((A).in[7])
#define IN_CONV_W(A) ((A).in[8])
#define IN_CONV_B(A) ((A).in[9])
#define IN_W_CONV_OUT(A) ((A).in[10])
#define IN_KV_NORM_G(A) ((A).in[11])
#define IN_W_ADA_KV(A) ((A).in[12])
#define IN_B_ADA_KV(A) ((A).in[13])
#define IN_W_KVF(A) ((A).in[14])
#define IN_B_FGATE(A) ((A).in[15])
#define IN_W_Q(A) ((A).in[16])
#define IN_W_O(A) ((A).in[17])
#define IN_FINAL_G(A) ((A).in[18])
#define WSF(A, off) ((float*)((A).ws + (off)))
#define WSB(A, off) ((bf16*)((A).ws + (off)))
#define P_ADA(A) WSF(A, WS_ADA)
#define P_LF(A) WSF(A, WS_LF)
#define P_FKR(A) WSF(A, WS_FKR)
#define P_PART(A) WSF(A, WS_OVL)
#define P_WFI(A) WSB(A, WS_WFI)
#define P_WFO(A) WSB(A, WS_WFO)
#define P_WCI(A) WSB(A, WS_WCI)
#define P_WCO(A) WSB(A, WS_WCO)
#define P_WQKV(A) WSB(A, WS_WQKV)
#define P_WO(A) WSB(A, WS_WO)
#define P_H(A) WSB(A, WS_H)
#define P_HID(A) WSB(A, WS_OVL)
#define P_BG(A) WSB(A, WS_OVL)
#define P_U(A) WSB(A, WS_OVL + 64 * MiB)
#define P_Z(A) WSB(A, WS_OVL + 128 * MiB)
#define P_Q(A) WSB(A, WS_OVL)
#define P_K(A) WSB(A, WS_OVL + 64 * MiB)
#define P_V(A) WSB(A, WS_OVL + 128 * MiB)
#define P_XB(A) WSB(A, WS_XB)
#define P_O(A) WSB(A, WS_OVL + 192 * MiB)
__device__ __forceinline__ float wave_sum(float v) {
#pragma unroll
    for (int o = 1; o < 64; o <<= 1) v += __shfl_xor(v, o);
    return v;
}
__device__ __forceinline__ float bf2f(unsigned short h) { return __uint_as_float((unsigned)h << 16); }

__device__ __forceinline__ void p0_ada_partials(const Frame& F, const Args& A) {
    PHASE_IDS;
    LAS float* cond = (LAS float*)(F.lds + RING_OFF);
    for (int i = tid; i < 2 * D; i += NWAVES * 64) { const float v = IN_C(A)[i]; cond[i] = v / (1.0f + __expf(-v)); }
    __syncthreads();
    const int gw = F.vcu * NWAVES + F.wave, NGW = F.G * NWAVES;
    constexpr int NCG = NADA_ALL / 256, NKC = D / 64;
    for (int it = gw; it < NCG * NKC; it += NGW) {
        const int cg = it % NCG, kc = it / NCG, n = cg * 256 + 4 * lane;
        const float* W; int ldw, nn;
        if (cg < NADA / 256) { W = IN_W_ADA(A); ldw = NADA; nn = n; } else if (cg < 2 * NADA / 256) { W = IN_W_ADA(A) + (size_t)D * NADA; ldw = NADA; nn = n - NADA; } else { W = IN_W_ADA_KV(A); ldw = 2 * D; nn = n - 2 * NADA; }
        const float* wp = W + (size_t)(kc * 64) * ldw + nn;
        f32x4 a0 = {0.f, 0.f, 0.f, 0.f}, a1 = {0.f, 0.f, 0.f, 0.f};
#pragma unroll 16
        for (int k = 0; k < 64; ++k) { const f32x4 w = *(const GAS f32x4*)(wp + (size_t)k * ldw); const float c0 = cond[kc * 64 + k], c1 = cond[D + kc * 64 + k]; a0 += w * c0; a1 += w * c1; }
        *(GAS f32x4*)(P_PART(A) + (size_t)(kc * 2 + 0) * NADA_ALL + n) = a0;
        *(GAS f32x4*)(P_PART(A) + (size_t)(kc * 2 + 1) * NADA_ALL + n) = a1;
    }
    __syncthreads();
}
__device__ __forceinline__ int dest_row(int n0, int P, int Hw) { if (n0 < P) return n0; int n1 = n0 - P, up = 0; if (n1 >= Hw) { n1 -= Hw; up = 128; } return P + 256 * (n1 >> 7) + up + (n1 & 127); }
__device__ __forceinline__ void p0_transpose_item(const float* W, int ldw, int K, int nblk, bf16* WT, int P, int Hw, LAS float* scr, int item, int lane) {
    const int kb = item / nblk, nb = item % nblk, k0 = 64 * kb, n0 = 32 * nb, r0 = dest_row(n0, P, Hw);
#pragma unroll 8
    for (int i = 0; i < 32; ++i) { const int kk = 2 * i + (lane >> 5); scr[kk * 33 + (lane & 31)] = W[(size_t)(k0 + kk) * ldw + n0 + (lane & 31)]; }
    LDS_WAIT(); asm volatile("" ::: "memory");
    const int c = lane & 7;
#pragma unroll
    for (int j = 0; j < 4; ++j) { const int n = (lane >> 3) + 8 * j; const LAS float* s = scr + (8 * c) * 33 + n;
        v4u o; o.x = pk2(s[0 * 33], s[1 * 33]); o.y = pk2(s[2 * 33], s[3 * 33]); o.z = pk2(s[4 * 33], s[5 * 33]); o.w = pk2(s[6 * 33], s[7 * 33]);
        *(GAS v4u*)(WT + (size_t)(r0 + n) * K + k0 + 8 * c) = o; }
    LDS_WAIT(); asm volatile("" ::: "memory");
}
__device__ __forceinline__ void p0_convert(const Frame& F, const Args& A) {
    PHASE_IDS;
    LAS float* scr = (LAS float*)(F.lds + RING_OFF + F.wave * 16384);
    const int gw = F.vcu * NWAVES + F.wave, NGW = F.G * NWAVES;
    constexpr int I_FI = (D / 64) * (2 * FF / 32), I_FO = (FF / 64) * (D / 32), I_CI = (D / 64) * (3 * D / 32), I_DD = (D / 64) * (D / 32), I_KV = (D / 64) * (2 * D / 32);
    constexpr int NITEMS = 4 * I_FI + 4 * I_FO + I_CI + I_DD + I_DD + I_KV + I_DD;
    for (int it = gw; it < NITEMS; it += NGW) {
        int r = it;
        if (r < 4 * I_FI) { const int i = r / I_FI; r -= i * I_FI; p0_transpose_item(IN_W_FFN_IN(A) + (size_t)i * D * 2 * FF, 2 * FF, D, 2 * FF / 32, P_WFI(A) + (size_t)i * 2 * FF * D, 0, FF, scr, r, lane); continue; } r -= 4 * I_FI;
        if (r < 4 * I_FO) { const int i = r / I_FO; r -= i * I_FO; p0_transpose_item(IN_W_FFN_OUT(A) + (size_t)i * FF * D, D, FF, D / 32, P_WFO(A) + (size_t)i * D * FF, D, 0, scr, r, lane); continue; } r -= 4 * I_FO;
        if (r < I_CI) { p0_transpose_item(IN_W_CONV_IN(A), 3 * D, D, 3 * D / 32, P_WCI(A), D, D, scr, r, lane); continue; } r -= I_CI;
        if (r < I_DD) { p0_transpose_item(IN_W_CONV_OUT(A), D, D, D / 32, P_WCO(A), D, 0, scr, r, lane); continue; } r -= I_DD;
        if (r < I_DD) { p0_transpose_item(IN_W_Q(A), D, D, D / 32, P_WQKV(A), D, 0, scr, r, lane); continue; } r -= I_DD;
        if (r < I_KV) { p0_transpose_item(IN_W_KVF(A), NKVF, D, 2 * D / 32, P_WQKV(A) + (size_t)D * D, 2 * D, 0, scr, r, lane); continue; } r -= I_KV;
        p0_transpose_item(IN_W_O(A), D, D, D / 32, P_WO(A), D, 0, scr, r, lane);
    }
    __syncthreads();
}
__device__ __forceinline__ void p1_ada_reduce(const Frame& F, const Args& A) {
    PHASE_IDS;
    for (int i = F.vcu * NWAVES * 64 + tid; i < 2 * NADA_ALL; i += F.G * NWAVES * 64) {
        const int b = i / NADA_ALL, n = i - b * NADA_ALL;
        float s = (n < 2 * NADA) ? IN_B_ADA(A)[n] : IN_B_ADA_KV(A)[n - 2 * NADA];
#pragma unroll 8
        for (int kc = 0; kc < D / 64; ++kc) s += P_PART(A)[(size_t)(kc * 2 + b) * NADA_ALL + n];
        P_ADA(A)[i] = s;
    }
}
__device__ __forceinline__ void unpack8(const v4u& w, f32x4& v0, f32x4& v1) {
    v0.x = __uint_as_float(w.x << 16); v0.y = __uint_as_float(w.x & 0xffff0000u); v0.z = __uint_as_float(w.y << 16); v0.w = __uint_as_float(w.y & 0xffff0000u);
    v1.x = __uint_as_float(w.z << 16); v1.y = __uint_as_float(w.z & 0xffff0000u); v1.z = __uint_as_float(w.w << 16); v1.w = __uint_as_float(w.w & 0xffff0000u); }
__device__ __forceinline__ v4u pack8(const f32x4& v0, const f32x4& v1) { v4u o; o.x = pk2(v0.x, v0.y); o.y = pk2(v0.z, v0.w); o.z = pk2(v1.x, v1.y); o.w = pk2(v1.z, v1.w); return o; }
template <bool FINAL, bool XBF16>
__device__ __forceinline__ void norm_phase(const Frame& F, const Args& A, const void* xin, const float* g, int ada_off, bf16* hout, float* fout) {
    PHASE_IDS;
    LAS float* ta = (LAS float*)(F.lds + RING_OFF); LAS float* tsh = ta + D;
    for (int rb = F.vcu; rb < M / 64; rb += F.G) {
        const int b = rb / (T / 64);
        for (int i = tid; i < D; i += NWAVES * 64) { const float gg = g[i];
            if (FINAL) { ta[i] = gg; } else { ta[i] = gg * (1.0f + P_ADA(A)[(size_t)b * NADA_ALL + ada_off + D + i]); tsh[i] = P_ADA(A)[(size_t)b * NADA_ALL + ada_off + i]; } }
        __syncthreads();
#pragma unroll 1
        for (int it = 0; it < 4; ++it) {
            asm volatile("" ::: "memory");
            const int r0 = rb * 64 + F.wave * 8 + it * 2;
            f32x4 xv[2][8]; float rs[2];
#pragma unroll
            for (int r = 0; r < 2; ++r) {
                if (XBF16) { const GAS v4u* xr = (const GAS v4u*)((const bf16*)xin + (size_t)(r0 + r) * D) + lane;
#pragma unroll
                    for (int j = 0; j < 4; ++j) { const v4u w = xr[64 * j]; unpack8(w, xv[r][2 * j], xv[r][2 * j + 1]); } }
                else { const GAS f32x4* xr = (const GAS f32x4*)((const float*)xin + (size_t)(r0 + r) * D) + lane;
#pragma unroll
                    for (int j = 0; j < 8; ++j) xv[r][j] = xr[64 * j]; } }
#pragma unroll
            for (int r = 0; r < 2; ++r) { float s = 0.f;
#pragma unroll
                for (int j = 0; j < 8; ++j) s += (xv[r][j].x * xv[r][j].x + xv[r][j].y * xv[r][j].y) + (xv[r][j].z * xv[r][j].z + xv[r][j].w * xv[r][j].w);
                rs[r] = 1.0f / sqrtf(wave_sum(s) * (1.0f / D) + EPS); }
            if (XBF16) {
#pragma unroll
                for (int j = 0; j < 4; ++j) { const int col = 8 * lane + 512 * j;
                    const f32x4 a0 = *(const LAS f32x4*)(ta + col), a1 = *(const LAS f32x4*)(ta + col + 4);
                    f32x4 s0 = {0.f, 0.f, 0.f, 0.f}, s1 = s0; if (!FINAL) { s0 = *(const LAS f32x4*)(tsh + col); s1 = *(const LAS f32x4*)(tsh + col + 4); }
#pragma unroll
                    for (int r = 0; r < 2; ++r) { const f32x4 v0 = xv[r][2 * j] * rs[r] * a0 + s0, v1 = xv[r][2 * j + 1] * rs[r] * a1 + s1;
                        if (FINAL) { GAS f32x4* o = (GAS f32x4*)(fout + (size_t)(r0 + r) * D + col); o[0] = v0; o[1] = v1; }
                        else { *(GAS v4u*)(hout + (size_t)(r0 + r) * D + col) = pack8(v0, v1); } } }
            } else {
#pragma unroll
                for (int j = 0; j < 8; ++j) { const f32x4 a = *(const LAS f32x4*)(ta + 4 * lane + 256 * j);
                    f32x4 sh = {0.f, 0.f, 0.f, 0.f}; if (!FINAL) sh = *(const LAS f32x4*)(tsh + 4 * lane + 256 * j);
#pragma unroll
                    for (int r = 0; r < 2; ++r) { const f32x4 v = xv[r][j] * rs[r] * a + sh;
                        if (FINAL) { *((GAS f32x4*)(fout + (size_t)(r0 + r) * D) + lane + 64 * j) = v; }
                        else { *((GAS unsigned long long*)(hout + (size_t)(r0 + r) * D) + lane + 64 * j) = (unsigned long long)pk2(v.x, v.y) | ((unsigned long long)pk2(v.z, v.w) << 32); } } }
            }
        }
        __syncthreads();
    }
}
__device__ __forceinline__ void fox_norm_phase(const Frame& F, const Args& A, const bf16* xin) {
    PHASE_IDS;
    LAS float* wfT = (LAS float*)(F.lds + RING_OFF);
    for (int cidx = tid; cidx < D; cidx += NWAVES * 64) { const GAS f32x4* src = (const GAS f32x4*)(IN_W_KVF(A) + (size_t)cidx * NKVF + 2 * D);
#pragma unroll
        for (int q = 0; q < 4; ++q) { const f32x4 w = src[q]; wfT[(4 * q + 0) * D + cidx] = w.x; wfT[(4 * q + 1) * D + cidx] = w.y; wfT[(4 * q + 2) * D + cidx] = w.z; wfT[(4 * q + 3) * D + cidx] = w.w; } }
    __syncthreads();
    const float* g1 = IN_NORM_G(A) + (size_t)(1 * 3 + 1) * D; const float* gk = IN_KV_NORM_G(A);
    for (int rb = F.vcu; rb < M / 64; rb += F.G) {
        const int b = rb / (T / 64);
        const float* ada1 = P_ADA(A) + (size_t)b * NADA_ALL + NADA + 3 * D;
        const float* adak = P_ADA(A) + (size_t)b * NADA_ALL + 2 * NADA;
#pragma unroll 1
        for (int it = 0; it < 4; ++it) {
            unsigned lo = (unsigned)lane * 32u; asm volatile("" : "+v"(lo) :: "memory");
            const int r0 = rb * 64 + F.wave * 8 + it * 2;
            const GAS char* x0 = (const GAS char*)(xin + (size_t)r0 * D);
            float rs[2];
            { v4u xr[2][4];
#pragma unroll
              for (int r = 0; r < 2; ++r)
#pragma unroll
                  for (int j = 0; j < 4; ++j) xr[r][j] = *(const GAS v4u*)(x0 + (size_t)r * D * 2 + j * 1024 + (lo >> 1));
#pragma unroll
              for (int r = 0; r < 2; ++r) { float s = 0.f;
#pragma unroll
                  for (int j = 0; j < 4; ++j) { f32x4 v0, v1; unpack8(xr[r][j], v0, v1); s += ((v0.x * v0.x + v0.y * v0.y) + (v0.z * v0.z + v0.w * v0.w)) + ((v1.x * v1.x + v1.y * v1.y) + (v1.z * v1.z + v1.w * v1.w)); }
                  rs[r] = 1.0f / sqrtf(wave_sum(s) * (1.0f / D) + EPS); } }
            float acc[32];
#pragma unroll
            for (int i = 0; i < 32; ++i) acc[i] = 0.f;
            GAS char* h0 = (GAS char*)(P_H(A) + (size_t)r0 * D); GAS char* k0p = (GAS char*)(P_H(A) + (size_t)M * D + (size_t)r0 * D);
#pragma unroll 1
            for (int j = 0; j < 4; ++j) {
                const unsigned jo = lo + (unsigned)j * 2048u;
                f32x4 a1[2], s1[2], a2[2], s2[2];
#pragma unroll
                for (int e = 0; e < 2; ++e) {
                    a1[e] = *(const GAS f32x4*)((const GAS char*)g1 + jo + 16 * e) * (*(const GAS f32x4*)((const GAS char*)(ada1 + D) + jo + 16 * e) + 1.0f); s1[e] = *(const GAS f32x4*)((const GAS char*)ada1 + jo + 16 * e);
                    a2[e] = *(const GAS f32x4*)((const GAS char*)gk + jo + 16 * e) * (*(const GAS f32x4*)((const GAS char*)(adak + D) + jo + 16 * e) + 1.0f); s2[e] = *(const GAS f32x4*)((const GAS char*)adak + jo + 16 * e); }
                f32x4 hk[2][2];
#pragma unroll
                for (int r = 0; r < 2; ++r) { f32x4 x0v, x1v; const v4u xw = *(const GAS v4u*)(x0 + (size_t)r * D * 2 + (jo >> 1)); unpack8(xw, x0v, x1v);
                    const f32x4 xn0 = x0v * rs[r], xn1 = x1v * rs[r];
                    hk[r][0] = xn0 * a2[0] + s2[0]; hk[r][1] = xn1 * a2[1] + s2[1];
                    *(GAS v4u*)(h0 + (size_t)r * D * 2 + (jo >> 1)) = pack8(xn0 * a1[0] + s1[0], xn1 * a1[1] + s1[1]);
                    *(GAS v4u*)(k0p + (size_t)r * D * 2 + (jo >> 1)) = pack8(hk[r][0], hk[r][1]); }
#pragma unroll
                for (int hh = 0; hh < 16; ++hh) { const f32x4 w0 = *(const LAS f32x4*)((const LAS char*)wfT + hh * (D * 4) + jo), w1 = *(const LAS f32x4*)((const LAS char*)wfT + hh * (D * 4) + jo + 16);
#pragma unroll
                    for (int r = 0; r < 2; ++r) acc[r * 16 + hh] += ((hk[r][0].x * w0.x + hk[r][0].y * w0.y) + (hk[r][0].z * w0.z + hk[r][0].w * w0.w)) + ((hk[r][1].x * w1.x + hk[r][1].y * w1.y) + (hk[r][1].z * w1.z + hk[r][1].w * w1.w)); } }
#pragma unroll
            for (int s = 0; s < 5; ++s) { const bool up = (lane >> s) & 1;
#pragma unroll
                for (int i = 0; i < (16 >> s); ++i) { const float a = acc[2 * i], bq = acc[2 * i + 1]; const float send = up ? a : bq, keep = up ? bq : a; acc[i] = keep + __shfl_xor(send, 1 << s); } }
            float z = acc[0] + __shfl_xor(acc[0], 32);
            z += IN_B_FGATE(A)[lane & 15];
            const float ls = fminf(z, 0.f) - log1pf(expf(-fabsf(z)));
            if (lane < 32) P_LF(A)[(size_t)(r0 + (lane >> 4)) * NH + (lane & 15)] = ls;
        }
    }
    __syncthreads();
}
__device__ __forceinline__ void scan_seq(const Frame& F, const Args& A, int seq) {
    PHASE_IDS;
    const int b = seq >> 4, h = seq & 15; const float* lf = P_LF(A) + (size_t)b * T * NH + h;
    float v[16]; float run = 0.f; const int s0 = tid * 16;
#pragma unroll
    for (int k = 0; k < 16; ++k) { run += lf[(size_t)(s0 + k) * NH]; v[k] = run; }
    float incl = run;
#pragma unroll
    for (int o = 1; o < 64; o <<= 1) { const float t = __shfl_up(incl, o); if (lane >= o) incl += t; }
    LAS float* wt = (LAS float*)(F.lds + RING_OFF);
    if (lane == 63) wt[F.wave] = incl;
    __syncthreads();
    float pre = incl - run;
    for (int w = 0; w < F.wave; ++w) pre += wt[w];
    float* o = P_FKR(A) + (size_t)seq * T + s0;
#pragma unroll
    for (int k = 0; k < 16; k += 4) { f32x4 q; q.x = -(pre + v[k]) * INV_SCALE; q.y = -(pre + v[k + 1]) * INV_SCALE; q.z = -(pre + v[k + 2]) * INV_SCALE; q.w = -(pre + v[k + 3]) * INV_SCALE; *(GAS f32x4*)(o + k) = q; }
    __syncthreads();
}
__device__ __forceinline__ void conv_phase(const Frame& F, const Args& A) {
    PHASE_IDS;
    const int half = tid >> 8, col = (tid & 255) * 8;
    float w0[8], w1[8], w2[8], cb[8];
#pragma unroll
    for (int e = 0; e < 8; ++e) { w0[e] = IN_CONV_W(A)[col + e]; w1[e] = IN_CONV_W(A)[D + col + e]; w2[e] = IN_CONV_W(A)[2 * D + col + e]; cb[e] = IN_CONV_B(A)[col + e]; }
    for (int rb = F.vcu; rb < M / 64; rb += F.G) {
        const int t0 = rb * 64 + half * 32;
        float um2[8], um1[8];
        if ((t0 & (T - 1)) != 0) { const bf16x8 a = *(const GAS bf16x8*)(P_U(A) + (size_t)(t0 - 2) * D + col), bq = *(const GAS bf16x8*)(P_U(A) + (size_t)(t0 - 1) * D + col);
#pragma unroll
            for (int e = 0; e < 8; ++e) { um2[e] = bf2f((unsigned short)a[e]); um1[e] = bf2f((unsigned short)bq[e]); } }
        else {
#pragma unroll
            for (int e = 0; e < 8; ++e) { um2[e] = 0.f; um1[e] = 0.f; } }
#pragma unroll 4
        for (int i = 0; i < 32; ++i) { const size_t off = (size_t)(t0 + i) * D + col;
            const bf16x8 uu = *(const GAS bf16x8*)(P_U(A) + off), gg = *(const GAS bf16x8*)(P_BG(A) + off);
            float z[8];
#pragma unroll
            for (int e = 0; e < 8; ++e) { const float uc = bf2f((unsigned short)uu[e]); z[e] = bf2f((unsigned short)gg[e]) * (w0[e] * um2[e] + w1[e] * um1[e] + w2[e] * uc + cb[e]); um2[e] = um1[e]; um1[e] = uc; }
            v4u o; o.x = pk2(z[0], z[1]); o.y = pk2(z[2], z[3]); o.z = pk2(z[4], z[5]); o.w = pk2(z[6], z[7]);
            *(GAS v4u*)(P_Z(A) + off) = o; }
    }
}
__device__ __forceinline__ fox::BlockRef<fox::bf16, fox::bf16> fox_ref(const Args& A, const fox::SwaItem& it, int pass) {
    const int qb = pass ? it.qb1 : it.qb0, b = it.bh >> 4, h = it.bh & 15; const size_t rowbase = (size_t)b * T;
    fox::BlockRef<fox::bf16, fox::bf16> r;
    r.Q = P_Q(A) + (rowbase + (size_t)qb * fox::QB) * D + h * HD; r.O = P_O(A) + (rowbase + (size_t)qb * fox::QB) * D + h * HD;
    r.K = P_K(A) + rowbase * D + h * HD; r.V = P_V(A) + rowbase * D + h * HD; r.F = P_FKR(A) + (size_t)it.bh * T; r.P0 = qb * fox::QB;
    return r;
}
#ifndef PHM
#define PHM 0x7fff
#endif
#ifndef REP_P0
#define REP_P0 1
#endif
#ifndef REP_NORM
#define REP_NORM 1
#endif
#ifndef REP_FI
#define REP_FI 1
#endif
#ifndef REP_CI
#define REP_CI 1
#endif
#ifndef REP_QKV
#define REP_QKV 1
#endif
#ifndef REP_ATT
#define REP_ATT 1
#endif
#ifndef REP_FO
#define REP_FO 1
#endif
#ifndef PROBE_RESID
#define PROBE_RESID 0
#endif
#ifndef PROBE_CLK
#define PROBE_CLK 0
#endif
#ifndef PROBE_BAR
#define PROBE_BAR 0
#endif
#ifndef PROBE_PV
#define PROBE_PV 0
#endif
#ifndef GEMM_SP2
#define GEMM_SP2 true
#endif
#ifndef REP_THIN
#define REP_THIN 1
#endif
#define REPEAT(n, ...) do { __VA_ARGS__ if ((n) > 1) { __VA_ARGS__ } if ((n) > 2) { __VA_ARGS__ } } while (0)
__device__ __forceinline__ void attn_phase(const Frame& F, const Args& A, char* ldsp) {
    using namespace fox;
    constexpr int nqb = SQ / QB, nramp = nqb, order = ORDER_PAIRED | ORDER_XCD, nx = (nramp + 1) / 2, total1 = nx * B * H, total = total1 * REP_ATT;
    const int stride = F.G; int L = blockIdx.x;
    if (L < total) {
        SwaItem it = swa_decode(L % total1, B, H, HKV, nqb, nx, nramp, order); int pass = 0;
        BlockRef<fox::bf16, fox::bf16> cur = fox_ref(A, it, 0);
        Seam<fox::bf16> S;
        causal_swa_prime<fox::bf16, fox::bf16>(cur, WINDOW, ldsp, S);
        for (;;) {
            const bool more_pass = pass == 0 && it.qb1 != it.qb0, more_item = L + stride < total, last = !more_pass && !more_item;
            SwaItem itn = it; int passn = pass + 1, Ln = L;
            if (!more_pass) { passn = 0; Ln = more_item ? L + stride : L; itn = swa_decode(Ln % total1, B, H, HKV, nqb, nx, nramp, order); }
            const BlockRef<fox::bf16, fox::bf16> nxt = last ? cur : fox_ref(A, itn, passn);
            causal_swa_block<fox::bf16, fox::bf16>(cur, nxt, SKV, WINDOW, ldsp, S);
            if (last) break;
            cur = nxt; it = itn; pass = passn; L = Ln;
        }
    }
}
template <int L>
__device__ __forceinline__ void mixout_phase(const Frame& F, const Args& A) {
#if PHM & 1024
    pg8::Gemm g{L == 0 ? P_Z(A) : P_O(A), L == 0 ? P_WCO(A) : P_WO(A), M, D, D}; pg8::StaticOrder S; S.init(M, D, F.G, (int)blockIdx.x);
    pg8::EpiResid<false> E{P_XB(A), P_XB(A), D, P_ADA(A) + (size_t)L * NADA + 5 * D, NADA_ALL, 1.0f};
    pg8::gemm_phase<pg8::EpiResid<false>, pg8::StaticOrder, true, GEMM_SP2>(F.lds + RING_OFF, g, S, E);
#endif
}
template <int L, int HALF>
__device__ __forceinline__ void ffn_block(const Frame& F, const Args& A, const XcdBarrier& bar, unsigned char* lds) {
    constexpr int sub = 2 * HALF, wi = L * 2 + HALF;
    constexpr bool FIRST = (L == 0 && HALF == 0);
    const void* xcur = FIRST ? (const void*)IN_X(A) : (const void*)P_XB(A);
#if PHM & 2048
    REPEAT(REP_NORM, norm_phase<false, !FIRST>(F, A, xcur, IN_NORM_G(A) + (size_t)(L * 3 + sub) * D, L * NADA + sub * 3 * D, P_H(A), nullptr););
#endif
    xcd_barrier(bar);
#if PROBE_CLK
    if (L == 0 && HALF == 0 && blockIdx.x == 0 && threadIdx.x == 0) { unsigned long long* st = (unsigned long long*)(A.ws + 512 * 1024); st[0] = clock64(); st[1] = wall_clock64(); }
#endif
#if PHM & 4096
    REPEAT(REP_FI, { pg8::Gemm g{P_H(A), P_WFI(A) + (size_t)wi * 2 * FF * D, M, 2 * FF, D}; pg8::StaticOrder S; S.init(M, 2 * FF, F.G, (int)blockIdx.x);
      pg8::EpiSwiglu E{P_HID(A), FF};
      pg8::gemm_phase<pg8::EpiSwiglu, pg8::StaticOrder, true, GEMM_SP2>(F.lds + RING_OFF, g, S, E); });
#endif
#if PROBE_CLK
    if (L == 0 && HALF == 0 && blockIdx.x == 0 && threadIdx.x == 0) { unsigned long long* st = (unsigned long long*)(A.ws + 512 * 1024); st[2] = clock64(); st[3] = wall_clock64(); }
#endif
    xcd_barrier(bar);
#if REP_FO > 1
    { pg8::Gemm g{P_HID(A), P_WFO(A) + (size_t)wi * D * FF, M, D, FF}; pg8::StaticOrder S; S.init(M, D, F.G, (int)blockIdx.x);
      pg8::EpiQKV E{P_O(A), 0, D};
      pg8::gemm_phase<pg8::EpiQKV, pg8::StaticOrder, true, GEMM_SP2, PROBE_PV>(F.lds + RING_OFF, g, S, E); }
#endif
#if PHM & 8192
    { pg8::Gemm g{P_HID(A), P_WFO(A) + (size_t)wi * D * FF, M, D, FF}; pg8::StaticOrder S; S.init(M, D, F.G, (int)blockIdx.x);
      pg8::EpiResid<FIRST> E{xcur, P_XB(A), D, P_ADA(A) + (size_t)L * NADA + (sub * 3 + 2) * D, NADA_ALL, 0.5f};
      pg8::gemm_phase<pg8::EpiResid<FIRST>, pg8::StaticOrder, true, GEMM_SP2>(F.lds + RING_OFF, g, S, E); }
#endif
    xcd_barrier(bar);
}
__global__ void __launch_bounds__(NWAVES * 64, 2) fwd_kernel(Args args) {
    extern __shared__ __attribute__((aligned(16))) unsigned char lds[];
    Frame F;
    F.lds = (LAS unsigned char*)lds;
    F.MISC = (volatile LAS unsigned*)(F.lds + MISC_OFF);
    F.wave = __builtin_amdgcn_readfirstlane((int)threadIdx.x >> 6);
    F.G = gridDim.x; { const int bx = blockIdx.x; F.vcu = (F.G % 8 == 0) ? (bx % 8) * (F.G / 8) + bx / 8 : bx; }
    const Args& A = args;
    for (int u = threadIdx.x; u < (LDS_BYTES - LDSCTL_OFF) / 4; u += NWAVES * 64) ((LAS unsigned*)(F.lds + LDSCTL_OFF))[u] = 0u;
    __syncthreads();
    XcdBarrier bar = xcd_barrier_post((unsigned*)(A.ws + WS_CTL) + CW_BAR, F.MISC + 8);
#define GRID_BAR() xcd_barrier(bar)
#if PROBE_BAR
    for (int i_ = 0; i_ < 32; ++i_) xcd_barrier(bar);
#endif

    REPEAT(REP_P0, p0_ada_partials(F, A); p0_convert(F, A););
    GRID_BAR();
#if PHM & 4
    p1_ada_reduce(F, A);
#endif
    GRID_BAR();

    ffn_block<0, 0>(F, A, bar, lds);
#if PHM & 8
    REPEAT(REP_NORM, norm_phase<false, true>(F, A, P_XB(A), IN_NORM_G(A) + (size_t)(0 * 3 + 1) * D, 0 * NADA + 3 * D, P_H(A), nullptr););
#endif
    GRID_BAR();
#if PHM & 16
    REPEAT(REP_CI, { pg8::Gemm g{P_H(A), P_WCI(A), M, 3 * D, D}; pg8::StaticOrder S; S.init(M, 3 * D, F.G, (int)blockIdx.x);
      pg8::EpiConvIn E{P_BG(A), P_U(A), D};
      pg8::gemm_phase<pg8::EpiConvIn, pg8::StaticOrder, true, GEMM_SP2>(F.lds + RING_OFF, g, S, E); });
#endif
    GRID_BAR();
#if PHM & 32
    REPEAT(REP_THIN, conv_phase(F, A););
#endif
    GRID_BAR();
#if PROBE_RESID == 2
    { pg8::Gemm g{P_Z(A), P_WCO(A), M, D, D}; pg8::StaticOrder S; S.init(M, D, F.G, (int)blockIdx.x);
      pg8::EpiQKV E{P_O(A), 0, D};
      pg8::gemm_phase<pg8::EpiQKV, pg8::StaticOrder, true, GEMM_SP2>(F.lds + RING_OFF, g, S, E); }
#endif
    mixout_phase<0>(F, A);
    GRID_BAR();
    ffn_block<0, 1>(F, A, bar, lds);
    ffn_block<1, 0>(F, A, bar, lds);
#if PHM & 64
    REPEAT(REP_THIN, fox_norm_phase(F, A, P_XB(A)););
#endif
    GRID_BAR();
#if PHM & 128
    if (F.vcu < BATCH * NH) scan_seq(F, A, F.vcu);
#endif
#if PHM & 256
    REPEAT(REP_QKV, { pg8::Gemm g{P_H(A), P_WQKV(A), 2 * M, 3 * D, D}; pg8::QkvOrder S; S.init(M, 3 * D, F.G, (int)blockIdx.x);
      pg8::EpiQKV E{P_Q(A), (size_t)64 * MiB / 2, D};
      pg8::gemm_phase<pg8::EpiQKV, pg8::QkvOrder, true, GEMM_SP2>(F.lds + RING_OFF, g, S, E); });
#endif
    GRID_BAR();
#if PHM & 512
    attn_phase(F, A, (char*)lds + RING_OFF);
#endif
    GRID_BAR();
    mixout_phase<1>(F, A);
    GRID_BAR();
    ffn_block<1, 1>(F, A, bar, lds);
#if PHM & 16384
    norm_phase<true, true>(F, A, P_XB(A), IN_FINAL_G(A), 0, nullptr, A.out);
#endif
#if PROBE_CLK
    if (blockIdx.x == 0 && threadIdx.x == 0) { volatile unsigned long long* st = (volatile unsigned long long*)(A.ws + 512 * 1024);
        const unsigned long long dc = st[2] - st[0], dw = st[3] - st[1];
        const unsigned long long wait_ticks = dw ? (dc * 10000ull) / dw : 0ull;
        const unsigned long long t0 = wall_clock64(); while (wall_clock64() - t0 < wait_ticks && wall_clock64() - t0 < 400000ull) __builtin_amdgcn_s_sleep(8); }
#endif
#undef GRID_BAR
}

extern "C" void kernel_launch(void* const* d_in, const int* in_sizes, int n_in, void* d_out, int out_size, void* d_ws, size_t ws_size, hipStream_t stream) {
    static int grid = 0;
    if (grid == 0) {
        if (n_in != 19 || in_sizes[0] != M * D || out_size != M * D || ws_size < WS_END) { fprintf(stderr, "kernel_launch: built for 19 inputs, x and out of %d floats, >= %zu bytes of workspace; got n_in %d, in0 %d, out %d, ws %zu; nothing launched\n", M * D, (size_t)WS_END, n_in, n_in > 0 ? in_sizes[0] : -1, out_size, ws_size); grid = -1; return; }
        int dev = 0, cus = 0, per_cu = 0;
        if (hipGetDevice(&dev) != hipSuccess || hipDeviceGetAttribute(&cus, hipDeviceAttributeMultiprocessorCount, dev) != hipSuccess) { fprintf(stderr, "kernel_launch: hipGetDevice / hipDeviceGetAttribute failed; nothing launched\n"); grid = -1; return; }
        if (hipFuncSetAttribute((const void*)fwd_kernel, hipFuncAttributeMaxDynamicSharedMemorySize, LDS_BYTES) != hipSuccess) { fprintf(stderr, "kernel_launch: hipFuncSetAttribute failed (%d bytes of dynamic LDS); nothing launched\n", LDS_BYTES); grid = -1; return; }
        if (hipOccupancyMaxActiveBlocksPerMultiprocessor(&per_cu, (const void*)fwd_kernel, NWAVES * 64, LDS_BYTES) != hipSuccess || per_cu < 1)
            fprintf(stderr, "kernel_launch: note: the occupancy query reports %d workgroups per CU\n", per_cu);
        (void)hipGetLastError();
        grid = cus;
    }
    if (grid < 0) return;
    if (hipMemsetAsync((char*)d_ws + WS_CTL, 0, CTL_ZERO_BYTES, stream) != hipSuccess) { fprintf(stderr, "kernel_launch: hipMemsetAsync of the control words failed; nothing launched\n"); return; }
    Args a{};
    for (int i = 0; i < 19; ++i) a.in[i] = (const float*)d_in[i];
    a.out = (float*)d_out; a.ws = (unsigned char*)d_ws;
    hipLaunchKernelGGL(fwd_kernel, dim3(grid), dim3(NWAVES * 64), LDS_BYTES, stream, a);
    const hipError_t le = hipPeekAtLastError();
    if (le != hipSuccess) fprintf(stderr, "kernel_launch: launch failed: %s (grid %d x %d threads, %d B LDS)\n", hipGetErrorName(le), grid, NWAVES * 64, LDS_BYTES);
}
```
